# Optimizing an MI355X kernel written in HIP

```python
import math
import jax, jax.numpy as jnp
from jax import lax
import numpy as np

D_MODEL = 2048
BATCH = 32
SEQ = 256
DEPTH = 4
DEC_BATCH = 8
DEC_SEQ = 4096
PAST_LEN = 256

GRID_W = 64
N_MIXERS = 3
N_POOL_LAYERS = (DEPTH + N_MIXERS - 1) // N_MIXERS
N_SGU_LAYERS = (DEPTH + N_MIXERS - 2) // N_MIXERS
N_ATTN_LAYERS = DEPTH // N_MIXERS
POOL_WINDOWS = (2, 4, 8, 16)
POOL_GROUPS = len(POOL_WINDOWS)
POOL_GROUP_DIM = D_MODEL // POOL_GROUPS
SGU_DIM = D_MODEL
SGU_GROUPS = 8
SGU_GROUP_DIM = SGU_DIM // SGU_GROUPS
SGU_CHUNK = 128
DA_HEAD_DIM = 128
DA_V_DIM = 2 * DA_HEAD_DIM
DA_HEADS = D_MODEL // DA_V_DIM
DA_QK_WIDTH = DA_HEADS * 2 * DA_HEAD_DIM
Q_BLOCK = 128
ROPE_BASE = 10000.0
ROPE_HALF = DA_HEAD_DIM // 4
FFN_HIDDEN = -(-8 * D_MODEL // (3 * 256)) * 256
N_MOD = 6
EPS = 1e-6

kernel_name = "hybrid_pool_sgu_diffattn_dit_step"


def rms_norm(x, g):
    xf = x.astype(jnp.float32)
    y = xf * lax.rsqrt(jnp.mean(xf * xf, axis=-1, keepdims=True) + EPS)
    return (y * g.astype(jnp.float32)).astype(x.dtype)


def ada_mod(cond, w, b):
    m = jax.nn.silu(cond) @ w + b
    return jnp.split(m[:, None, :], N_MOD, axis=-1)


def modulate(h, shift, scale):
    return h * (1 + scale) + shift


def multiscale_pool(h, w, scale):
    B, n, _ = h.shape
    hg = h.reshape(B, n, POOL_GROUPS, POOL_GROUP_DIM)
    cs = jnp.pad(jnp.cumsum(hg.astype(jnp.float32), axis=1), ((0, 0), (1, 0), (0, 0), (0, 0)))
    t = jnp.arange(n)
    pooled = []
    for g, win in enumerate(POOL_WINDOWS):
        lo = jnp.clip(t - win // 2, 0, n)
        hi = jnp.clip(t - win // 2 + win, 0, n)
        cnt = (hi - lo).astype(jnp.float32)
        pooled.append((cs[:, hi, g] - cs[:, lo, g]) / cnt[:, None])
    d = jnp.stack(pooled, axis=2) - hg.astype(jnp.float32)
    y = jnp.einsum('bngc,gcd->bngd', d.astype(h.dtype), w)
    return y.reshape(B, n, D_MODEL) * scale


def spatial_gating_mlp(h, w_in, norm_g, ws, bs, w_out):
    B, n, _ = h.shape
    z = jax.nn.gelu(h @ w_in, approximate=False)
    u, v = jnp.split(z, 2, axis=-1)
    v = rms_norm(v, norm_g).reshape(B, n // SGU_CHUNK, SGU_CHUNK, SGU_GROUPS, SGU_GROUP_DIM)
    v = jnp.einsum('gpq,bcqge->bcpge', ws, v) + bs.T[:, :, None]
    return (u * v.reshape(B, n, SGU_DIM)) @ w_out


def axial_rope_tables(n_tokens):
    rows = n_tokens // GRID_W
    row = jnp.broadcast_to(jnp.arange(rows, dtype=jnp.float32)[:, None], (rows, GRID_W)).reshape(-1)
    col = jnp.broadcast_to(jnp.arange(GRID_W, dtype=jnp.float32)[None, :], (rows, GRID_W)).reshape(-1)
    inv = ROPE_BASE ** (-jnp.arange(ROPE_HALF, dtype=jnp.float32) / ROPE_HALF)
    ang = jnp.stack([row[:, None] * inv, col[:, None] * inv], axis=1)
    return jnp.cos(ang), jnp.sin(ang)


def apply_axial_rope(x, cos, sin):
    xs = x.reshape(x.shape[:-1] + (2, 2, ROPE_HALF)).astype(jnp.float32)
    x1, x2 = xs[..., 0, :], xs[..., 1, :]
    c = cos[:, None, None]
    s = sin[:, None, None]
    out = jnp.stack([x1 * c - x2 * s, x2 * c + x1 * s], axis=-2)
    return out.reshape(x.shape).astype(x.dtype)


def diff_qkv(h, w):
    B, n, _ = h.shape
    q, k, v = jnp.split(h @ w, [DA_QK_WIDTH, 2 * DA_QK_WIDTH], axis=-1)
    return (q.reshape(B, n, DA_HEADS, 2, DA_HEAD_DIM),
            k.reshape(B, n, DA_HEADS, 2, DA_HEAD_DIM),
            v.reshape(B, n, DA_HEADS, DA_V_DIM))


def diff_lambda(lp, lam_init):
    lp = lp.astype(jnp.float32)
    return jnp.exp(jnp.sum(lp[0] * lp[1])) - jnp.exp(jnp.sum(lp[2] * lp[3])) + lam_init


def diff_attention(q, k, v, lam):
    B, n = q.shape[:2]
    nb = n // Q_BLOCK
    qb = q.reshape((B, nb, Q_BLOCK) + q.shape[2:]).swapaxes(0, 1)
    sc = DA_HEAD_DIM ** -0.5

    def block(qi):
        s = jnp.einsum('bqhmd,bkhmd->bhmqk', qi, k, preferred_element_type=jnp.float32) * sc
        p = jax.nn.softmax(s, axis=-1)
        p = p[:, :, 0] - lam * p[:, :, 1]
        return jnp.einsum('bhqk,bkhe->bqhe', p.astype(v.dtype), v)

    o = lax.map(block, qb)
    return o.swapaxes(0, 1).reshape(B, n, DA_HEADS, DA_V_DIM)


def diff_attn_out(o, subln_g, w_o, lam_init):
    B, n = o.shape[:2]
    o = rms_norm(o, subln_g) * (1.0 - lam_init)
    return o.reshape(B, n, DA_HEADS * DA_V_DIM) @ w_o


def swiglu(h, w_in, w_out):
    a, b = jnp.split(h @ w_in, 2, axis=-1)
    return (jax.nn.silu(a) * b) @ w_out


def setup_inputs(seed: int = 0) -> dict:
    key = jax.random.key(seed)
    ks = jax.random.split(key, 26)
    D = D_MODEL

    def nrm(k, shape, s):
        return jax.random.normal(k, shape, jnp.float32) * s

    return {
        "x_prompt": nrm(ks[0], (BATCH, SEQ, D), 1.0),
        "x_sample": nrm(ks[1], (DEC_BATCH, DEC_SEQ, D), 1.0),
        "cache_k": nrm(ks[2], (DEC_BATCH, N_ATTN_LAYERS, PAST_LEN, DA_HEADS, 2, DA_HEAD_DIM), 1.0),
        "cache_v": nrm(ks[3], (DEC_BATCH, N_ATTN_LAYERS, PAST_LEN, DA_HEADS, DA_V_DIM), 1.0),
        "c": nrm(ks[4], (DEC_BATCH, D), 1.0),
        "c_ctx": nrm(ks[5], (D,), 1.0),
        "ada_w": nrm(ks[6], (DEPTH, D, N_MOD * D), 0.5 * D ** -0.5),
        "ada_b": nrm(ks[7], (DEPTH, N_MOD * D), 0.02),
        "norm_mix_g": 1.0 + nrm(ks[8], (DEPTH, D), 0.05),
        "norm_ffn_g": 1.0 + nrm(ks[9], (DEPTH, D), 0.05),
        "pool_w": nrm(ks[10], (N_POOL_LAYERS, POOL_GROUPS, POOL_GROUP_DIM, POOL_GROUP_DIM), POOL_GROUP_DIM ** -0.5),
        "pool_scale": 1.0 + nrm(ks[11], (N_POOL_LAYERS, D), 0.1),
        "sgu_w_in": nrm(ks[12], (N_SGU_LAYERS, D, 2 * SGU_DIM), D ** -0.5),
        "sgu_norm_g": 1.0 + nrm(ks[13], (N_SGU_LAYERS, SGU_DIM), 0.05),
        "sgu_ws": nrm(ks[14], (N_SGU_LAYERS, SGU_GROUPS, SGU_CHUNK, SGU_CHUNK), SGU_CHUNK ** -0.5),
        "sgu_b": 1.0 + nrm(ks[15], (N_SGU_LAYERS, SGU_GROUPS, SGU_CHUNK), 0.1),
        "sgu_w_out": nrm(ks[16], (N_SGU_LAYERS, SGU_DIM, D), SGU_DIM ** -0.5),
        "attn_w_qkv": nrm(ks[17], (N_ATTN_LAYERS, D, 2 * DA_QK_WIDTH + DA_HEADS * DA_V_DIM), D ** -0.5),
        "attn_lambda": nrm(ks[18], (N_ATTN_LAYERS, 4, DA_HEAD_DIM), 0.1),
        "attn_subln_g": 1.0 + nrm(ks[19], (N_ATTN_LAYERS, DA_V_DIM), 0.05),
        "attn_w_o": nrm(ks[20], (N_ATTN_LAYERS, DA_HEADS * DA_V_DIM, D), (DA_HEADS * DA_V_DIM) ** -0.5),
        "ffn_w_in": nrm(ks[21], (DEPTH, D, 2 * FFN_HIDDEN), D ** -0.5),
        "ffn_w_out": nrm(ks[22], (DEPTH, FFN_HIDDEN, D), FFN_HIDDEN ** -0.5),
        "final_g": 1.0 + nrm(ks[23], (D,), 0.05),
    }


def reference(x_prompt, x_sample, cache_k, cache_v, c, c_ctx, ada_w, ada_b, norm_mix_g, norm_ffn_g,
              pool_w, pool_scale, sgu_w_in, sgu_norm_g, sgu_ws, sgu_b, sgu_w_out,
              attn_w_qkv, attn_lambda, attn_subln_g, attn_w_o, ffn_w_in, ffn_w_out, final_g):
    xc = x_prompt
    xl = x_sample
    cos, sin = axial_rope_tables(xl.shape[1])
    new_k, new_v = [], []
    for i in range(DEPTH):
        kind = i % N_MIXERS
        slot = i // N_MIXERS
        mc = ada_mod(c_ctx[None, :], ada_w[i], ada_b[i])
        ml = ada_mod(c, ada_w[i], ada_b[i])
        hc = modulate(rms_norm(xc, norm_mix_g[i]), mc[0], mc[1])
        hl = modulate(rms_norm(xl, norm_mix_g[i]), ml[0], ml[1])
        if kind == 0:
            oc = multiscale_pool(hc, pool_w[slot], pool_scale[slot])
            ol = multiscale_pool(hl, pool_w[slot], pool_scale[slot])
        elif kind == 1:
            sgu_args = (sgu_w_in[slot], sgu_norm_g[slot], sgu_ws[slot], sgu_b[slot], sgu_w_out[slot])
            oc = spatial_gating_mlp(hc, *sgu_args)
            ol = spatial_gating_mlp(hl, *sgu_args)
        else:
            lam_init = 0.8 - 0.6 * math.exp(-0.3 * i)
            lam = diff_lambda(attn_lambda[slot], lam_init)
            qc, kc, vc = diff_qkv(hc, attn_w_qkv[slot])
            ql, kl, vl = diff_qkv(hl, attn_w_qkv[slot])
            ql = apply_axial_rope(ql, cos, sin)
            kl = apply_axial_rope(kl, cos, sin)
            new_k.append(kc)
            new_v.append(vc)
            oc = diff_attention(qc, kc, vc, lam)
            k_all = jnp.concatenate([cache_k[:, slot].astype(kl.dtype), kl], axis=1)
            v_all = jnp.concatenate([cache_v[:, slot].astype(vl.dtype), vl], axis=1)
            ol = diff_attention(ql, k_all, v_all, lam)
            oc = diff_attn_out(oc, attn_subln_g[slot], attn_w_o[slot], lam_init)
            ol = diff_attn_out(ol, attn_subln_g[slot], attn_w_o[slot], lam_init)
        xc = xc + mc[2] * oc
        xl = xl + ml[2] * ol
        hc = modulate(rms_norm(xc, norm_ffn_g[i]), mc[3], mc[4])
        hl = modulate(rms_norm(xl, norm_ffn_g[i]), ml[3], ml[4])
        xc = xc + mc[5] * swiglu(hc, ffn_w_in[i], ffn_w_out[i])
        xl = xl + ml[5] * swiglu(hl, ffn_w_in[i], ffn_w_out[i])
    y_prompt = rms_norm(xc, final_g)
    y_sample = rms_norm(xl, final_g)
    new_cache_k = jnp.stack(new_k, axis=1)
    new_cache_v = jnp.stack(new_v, axis=1)
    return (y_prompt, y_sample, new_cache_k, new_cache_v)
```

```cpp
#include <hip/hip_runtime.h>
#include <hip/hip_bf16.h>
#include <cstdio>
#include <cstdint>

#ifndef MK_ONE_LAUNCH
#define MK_ONE_LAUNCH 1
#endif

#define GAS __attribute__((address_space(1)))
#define LAS __attribute__((address_space(3)))
typedef unsigned short bf16_t;
typedef short bf16x8 __attribute__((ext_vector_type(8)));
typedef short s16x4 __attribute__((ext_vector_type(4)));
typedef float f32x4 __attribute__((ext_vector_type(4)));
typedef float f32x2 __attribute__((ext_vector_type(2)));
typedef float f32x16 __attribute__((ext_vector_type(16)));
typedef unsigned u32x4 __attribute__((ext_vector_type(4)));
typedef unsigned u32x2 __attribute__((ext_vector_type(2)));

constexpr int DM = 2048, NCTX = 8192, NLAT = 32768, MROWS = NCTX + NLAT, FFH = 5632, NMOD = 6 * DM;
constexpr int LATSEQ = 4096, CTXSEQ = 256, PAST = 256, KVLEN = PAST + LATSEQ;
constexpr float EPS = 1e-6f;
constexpr float LAM_INIT = 0.47071301834358416f;

constexpr size_t MiB = 1u << 20;
constexpr size_t WS_CTL = 0, CTL_ZERO_BYTES = 1 * MiB;
constexpr size_t WS_MOD = 1 * MiB;
constexpr size_t WS_ROPE = 3 * MiB;
constexpr size_t WS_RSTD = 4 * MiB;
constexpr size_t WS_VSS = 5 * MiB;
constexpr size_t WS_SGUWS = 10 * MiB;
constexpr size_t WS_POOLW = 11 * MiB;
constexpr size_t WS_SGUIN = 15 * MiB;
constexpr size_t WS_SGUOUT = 31 * MiB;
constexpr size_t WS_WQKV = 39 * MiB;
constexpr size_t WS_WO = 63 * MiB;
constexpr size_t WS_FFNIN = 71 * MiB;
constexpr size_t WS_FFNOUT = 247 * MiB;
constexpr size_t WS_X = 336 * MiB;
constexpr size_t WS_H = 656 * MiB;
constexpr size_t WS_HID = 816 * MiB;
constexpr size_t WS_Q = 816 * MiB;
constexpr size_t WS_KALL = 976 * MiB;
constexpr size_t WS_VALL = 1112 * MiB;
constexpr size_t WS_KC = 1248 * MiB;
constexpr size_t WS_VC = 1280 * MiB;
constexpr size_t WS_ATTS = 1312 * MiB;
constexpr size_t WS_SSQ = 1376 * MiB;
constexpr size_t WS_SW = 1381 * MiB;
constexpr size_t WS_END = 1384 * MiB;
constexpr int SW_G1_L = 9 * 2 * FFH, SW_SGU = 4 * SW_G1_L, SW_QKV = SW_SGU + 9 * 4096, SW_TOTAL = SW_QKV + 9 * 6144;
static_assert((size_t)SW_TOTAL * 4 <= 2 * MiB, "shift@W tables");
constexpr size_t FFNIN_L = (size_t)2 * FFH * DM * 2, FFNOUT_L = (size_t)DM * FFH * 2;

constexpr int CW_BAR = 4096;

constexpr int RING_BYTES = 131072;
constexpr int LDS_BYTES = 163840;
constexpr int LDSCTL_OFF = LDS_BYTES - 256, MISC_OFF = LDSCTL_OFF;
constexpr int RT_OFF = RING_BYTES, TAB_FLOATS = 512, SSX_FLOATS = 1024, STG_FLOAT_OFF = 2 * 512 + 2 * 1024;
constexpr int RT_DOC = 0;

constexpr int NPH = 22;
__host__ __device__ inline bool phase_nonempty(int p) { return !(p == 3 || p == 18); }

__device__ __forceinline__ unsigned cvt_pk_bf16(float lo, float hi) { unsigned r; asm volatile("v_cvt_pk_bf16_f32 %0, %1, %2" : "=v"(r) : "v"(lo), "v"(hi)); return r; }
__device__ __forceinline__ f32x4 bf4_to_f4(u32x2 d) { return (f32x4){__uint_as_float(d.x << 16), __uint_as_float(d.x & 0xffff0000u), __uint_as_float(d.y << 16), __uint_as_float(d.y & 0xffff0000u)}; }
typedef _Float16 h16x2 __attribute__((ext_vector_type(2)));
typedef _Float16 h16x4 __attribute__((ext_vector_type(4)));
__device__ __forceinline__ unsigned pk_f16(float a, float b) { const h16x2 h = __builtin_convertvector((f32x2){a, b}, h16x2); return __builtin_bit_cast(unsigned, h); }
__device__ __forceinline__ f32x4 h4_to_f4(u32x2 d) { const h16x4 h = __builtin_bit_cast(h16x4, d); return __builtin_convertvector(h, f32x4); }
__device__ __forceinline__ float bf2f(bf16_t b) { return __uint_as_float(((unsigned)b) << 16); }
__device__ __forceinline__ bf16_t f2bf(float f) { return (bf16_t)(cvt_pk_bf16(f, 0.f) & 0xffffu); }
__device__ __forceinline__ int opaque_tid() { int t = threadIdx.x; asm volatile("" : "+v"(t)); return t; }
__device__ __forceinline__ float add_xor1(float x) { return x + __builtin_bit_cast(float, __builtin_amdgcn_update_dpp(0, __builtin_bit_cast(int, x), 0xB1, 0xF, 0xF, true)); }
__device__ __forceinline__ float add_xor2(float x) { return x + __builtin_bit_cast(float, __builtin_amdgcn_update_dpp(0, __builtin_bit_cast(int, x), 0x4E, 0xF, 0xF, true)); }
__device__ __forceinline__ float add_xor16(float x) { return x + __builtin_bit_cast(float, __builtin_amdgcn_ds_swizzle(__builtin_bit_cast(int, x), 0x401F)); }
__device__ __forceinline__ float add_xor32(float x) { auto r = __builtin_amdgcn_permlane32_swap(__builtin_bit_cast(unsigned, x), __builtin_bit_cast(unsigned, x), false, false); return __uint_as_float(r[0]) + __uint_as_float(r[1]); }
__device__ __forceinline__ float wave_sum(float v) {
    v = add_xor1(v); v = add_xor2(v);
    v += __builtin_bit_cast(float, __builtin_amdgcn_update_dpp(0, __builtin_bit_cast(int, v), 0x141, 0xF, 0xF, true));
    v += __builtin_bit_cast(float, __builtin_amdgcn_update_dpp(0, __builtin_bit_cast(int, v), 0x140, 0xF, 0xF, true));
    v = add_xor16(v); return add_xor32(v);
}
__device__ __forceinline__ float dot4(f32x4 a) { return (a.x * a.x + a.y * a.y) + (a.z * a.z + a.w * a.w); }

namespace pg8 {
constexpr int BM = 256, BK = 64, HALF = 128, HTB = HALF * BK * 2, STAGE_BYTES = 8 * HTB, NXCD = 8;
__host__ __device__ __forceinline__ int lds_byte(int r, int c) { const int st = (r >> 4) * 2 + (c >> 5), rr = r & 15, cc = c & 31, ob = rr * 64 + cc * 2; return st * 1024 + (ob ^ (((ob >> 9) & 1) << 5)); }
__host__ __device__ __forceinline__ void stage_rc(int b, int& R, int& C) { const int st = b / 1024, sb = b % 1024, swz = sb ^ (((sb >> 9) & 1) << 5); R = (st >> 1) * 16 + swz / 64; C = (st & 1) * 32 + (swz % 64) / 2; }
__host__ __device__ __forceinline__ int perm32(int rho) { const int n = rho >> 4, i = rho & 15; return 8 * (i >> 2) + 4 * n + (i & 3); }

struct Unit { int pm, pn; };
struct Gemm { const bf16_t* A; const bf16_t* Bt; int lda, K, agrp; unsigned kstepA; size_t tstepA; };
__host__ __device__ __forceinline__ Gemm mk_gemm(const bf16_t* A, const bf16_t* Bt, int lda, int K, int agrp = 0) { return Gemm{A, Bt, lda, K, agrp, (unsigned)(BK * 2), (size_t)BM * lda * 2}; }

struct StaticOrder {
    int nM, nN, nwg, G, c, WGM, rev;
    __host__ __device__ void init(int M, int N, int G_, int c_, int wgm = 8, int rev_ = 0) { nM = M / BM; nN = N / BM; nwg = nM * nN; G = G_; c = c_; WGM = wgm; rev = rev_; }
    __host__ __device__ bool next(int i, Unit& u) const {
        const long L = (long)i * G + c; if (L >= nwg) return false;
        int wgid = (int)L; { const int q = nwg / NXCD, r = nwg % NXCD, xcd = wgid % NXCD, off = wgid / NXCD; wgid = (xcd < r ? xcd * (q + 1) : r * (q + 1) + (xcd - r) * q) + off; }
        const int nig = WGM * nN, gid = wgid / nig, fm = gid * WGM, gsz = (nM - fm) < WGM ? (nM - fm) : WGM;
        u.pm = fm + ((wgid % nig) % gsz); u.pn = (wgid % nig) / gsz; if (rev) u.pm = nM - 1 - u.pm; return true;
    }
};

__device__ __forceinline__ f32x2 gelu_pk(f32x2 v) {
    const f32x2 av = __builtin_elementwise_abs(v), d = av * 0.2316418882f + 1.0f;
    f32x2 t; t.x = __builtin_amdgcn_rcpf(d.x); t.y = __builtin_amdgcn_rcpf(d.y);
    f32x2 q = t * 0.5307027145f + (-0.7265760135f); q = q * t + 0.7107068705f; q = q * t + (-0.142248368f); q = q * t + 0.127414796f; q = q * t;
    const f32x2 s = (v * v) * (-0.72134752044f);
    f32x2 e; e.x = __builtin_amdgcn_exp2f(s.x); e.y = __builtin_amdgcn_exp2f(s.y);
    const f32x2 m = v * (q * e), r = v - m;
    f32x2 o; o.x = v.x < 0.f ? m.x : r.x; o.y = v.y < 0.f ? m.y : r.y; return o;
}

__device__ __forceinline__ int ci_of_pm(int pm) { return pm < 32 ? 8 : ((pm - 32) >> 4); }


struct EpiRes {
    static constexpr bool PERM = true, HAS_PREF = true;
    const float* xin0; const float* xin1;
    const bf16_t* xin16;
    bf16_t* xout; const float* gate;
    const float* cscale;
    float* ssq; bf16_t* xg; const float* gnext; const float* scnext;
    __device__ __forceinline__ void pref_direct(const Unit& u, LAS float* tab, int tid) const {
        if (tid < 64) { const int ci = ci_of_pm(u.pm), c4 = u.pn * BM + tid * 4; f32x4 g = *(const f32x4*)(gate + (size_t)ci * NMOD + c4);
            if (cscale) g = g * *(const f32x4*)(cscale + c4);
            *(LAS f32x4*)(tab + tid * 4) = g;
            if (xg) *(LAS f32x4*)(tab + 256 + tid * 4) = *(const f32x4*)(gnext + c4) * (*(const f32x4*)(scnext + (size_t)ci * NMOD + c4) + 1.0f); }
    }
    __device__ __forceinline__ void pref_dma(const Unit& u, LAS float* stg, int wid, int lane) const {
        const int ci = ci_of_pm(u.pm), c4 = u.pn * BM + lane * 4, v = wid & 3;
        const float* gsrc = gate + (size_t)ci * NMOD;
        const float* src = (v == 0) ? gsrc : (v == 1) ? (cscale ? cscale : gsrc) : (v == 2) ? (xg ? gnext : gsrc) : (xg ? scnext + (size_t)ci * NMOD : gsrc);
        __builtin_amdgcn_global_load_lds((const unsigned*)(src + c4), (LAS unsigned*)(stg + v * 256), 16, 0, 0);
    }
    __device__ __forceinline__ void pref_commit(const LAS float* stg, LAS float* tab, int tid) const {
        if (tid < 64) { f32x4 g = *(const LAS f32x4*)(stg + tid * 4); if (cscale) g = g * *(const LAS f32x4*)(stg + 256 + tid * 4);
            *(LAS f32x4*)(tab + tid * 4) = g;
            if (xg) *(LAS f32x4*)(tab + 256 + tid * 4) = *(const LAS f32x4*)(stg + 512 + tid * 4) * (*(const LAS f32x4*)(stg + 768 + tid * 4) + 1.0f); }
    }
    __device__ __forceinline__ void operator()(const f32x4 (&acc)[2][2][4][2], const Unit& u, int wr, int wc, int fr, int fq, const LAS float* tab, LAS float* ssx) const {
        const int row0 = u.pm * BM + wr * 64 + fr, col0 = u.pn * BM + wc * 32 + 8 * fq;
        const LAS float* tg = tab + wc * 32 + 8 * fq;
        const float* xb = (u.pm < 32) ? xin0 : xin1; const int radj = (u.pm < 32) ? 0 : NCTX;
#define RES_BODY(ai, m0, NM, XLOAD0, XLOAD1) \
            _Pragma("unroll") for (int m_ = 0; m_ < NM; ++m_) { const int m = (m0) + m_; const int row = row0 + (ai) * HALF + m * 16; bf16_t* xo = xout + (size_t)row * DM + col0; float ss = 0.f; \
                _Pragma("unroll") for (int bj = 0; bj < 2; ++bj) { const f32x4 g0 = *(const LAS f32x4*)(tg + bj * HALF), g1 = *(const LAS f32x4*)(tg + bj * HALF + 4); \
                    const f32x4 x0 = (XLOAD0) + g0 * acc[ai][bj][m][0], x1 = (XLOAD1) + g1 * acc[ai][bj][m][1]; \
                    { u32x4 w; w.x = pk_f16(x0[0], x0[1]); w.y = pk_f16(x0[2], x0[3]); w.z = pk_f16(x1[0], x1[1]); w.w = pk_f16(x1[2], x1[3]); *(u32x4*)(xo + bj * HALF) = w; } \
                    ss += dot4(x0) + dot4(x1); \
                    if (xg) { const f32x4 h0 = x0 * *(const LAS f32x4*)(tg + 256 + bj * HALF), h1 = x1 * *(const LAS f32x4*)(tg + 256 + bj * HALF + 4); \
                        u32x4 w; w.x = cvt_pk_bf16(h0[0], h0[1]); w.y = cvt_pk_bf16(h0[2], h0[3]); w.z = cvt_pk_bf16(h1[0], h1[1]); w.w = cvt_pk_bf16(h1[2], h1[3]); \
                        *(u32x4*)(xg + (size_t)row * DM + col0 + bj * HALF) = w; } } \
                if (ssq) { ss = add_xor16(ss); ss = add_xor32(ss); if (fq == 0) ssx[((ai) * HALF + wr * 64 + m * 16 + fr) * 4 + wc] = ss; } }
#define RES_ROWS32(ai, m0, NM) do { f32x4 xv[NM][2][2]; \
            _Pragma("unroll") for (int m_ = 0; m_ < NM; ++m_) { const float* xr = xb + (size_t)(row0 + (ai) * HALF + ((m0) + m_) * 16 - radj) * DM + col0; \
                _Pragma("unroll") for (int bj = 0; bj < 2; ++bj) _Pragma("unroll") for (int n = 0; n < 2; ++n) xv[m_][bj][n] = *(const f32x4*)(xr + bj * HALF + n * 4); } \
            RES_BODY(ai, m0, NM, xv[m_][bj][0], xv[m_][bj][1]) } while (0)
#define RES_ROWS16(ai, m0, NM) do { u32x4 xv[NM][2]; \
            _Pragma("unroll") for (int m_ = 0; m_ < NM; ++m_) { const bf16_t* xr = xin16 + (size_t)(row0 + (ai) * HALF + ((m0) + m_) * 16) * DM + col0; \
                _Pragma("unroll") for (int bj = 0; bj < 2; ++bj) xv[m_][bj] = *(const u32x4*)(xr + bj * HALF); } \
            RES_BODY(ai, m0, NM, h4_to_f4((u32x2){xv[m_][bj].x, xv[m_][bj].y}), h4_to_f4((u32x2){xv[m_][bj].z, xv[m_][bj].w})) } while (0)
        if (xin16) { RES_ROWS16(0, 0, 4); RES_ROWS16(1, 0, 4); }
        else { RES_ROWS32(0, 0, 4); RES_ROWS32(1, 0, 4); }
#undef RES_ROWS32
#undef RES_ROWS16
#undef RES_BODY
    }
    __device__ __forceinline__ void post(const Unit& u, const LAS float* ssx, int tid) const {
        if (ssq && tid < 256) { const f32x4 v = *(const LAS f32x4*)(ssx + tid * 4); int t4 = tid; asm volatile("" : "+v"(t4)); *(float*)((char*)(ssq + (size_t)u.pm * BM * 8 + u.pn) + (unsigned)t4 * 32u) = (v.x + v.y) + (v.z + v.w); }
    }
};

struct EpiDelta {
    static constexpr bool PERM = true, HAS_PREF = false;
    bf16_t* D; const float* gate; const float* cscale;
    __device__ __forceinline__ void pref_direct(const Unit&, LAS float*, int) const {}
    __device__ __forceinline__ void pref_dma(const Unit&, LAS float*, int, int) const {}
    __device__ __forceinline__ void pref_commit(const LAS float*, LAS float*, int) const {}
    __device__ __forceinline__ void post(const Unit&, const LAS float*, int) const {}
    __device__ __forceinline__ void operator()(const f32x4 (&acc)[2][2][4][2], const Unit& u, int wr, int wc, int fr, int fq, const LAS float*, LAS float*) const {
        const int ci = ci_of_pm(u.pm);
        const float* gp = gate + (size_t)ci * NMOD;
        const int row0 = u.pm * BM + wr * 64 + fr, col0 = u.pn * BM + wc * 32 + 8 * fq;
        f32x4 gv[2][2];
#pragma unroll
        for (int bj = 0; bj < 2; ++bj)
#pragma unroll
            for (int n = 0; n < 2; ++n) { gv[bj][n] = *(const f32x4*)(gp + col0 + bj * HALF + n * 4); if (cscale) gv[bj][n] = gv[bj][n] * *(const f32x4*)(cscale + col0 + bj * HALF + n * 4); }
#pragma unroll
        for (int ai = 0; ai < 2; ++ai)
#pragma unroll
            for (int m = 0; m < 4; ++m) { bf16_t* rowp = D + (size_t)(row0 + ai * HALF + m * 16) * DM + col0;
#pragma unroll
                for (int bj = 0; bj < 2; ++bj) { const f32x4 v0 = acc[ai][bj][m][0] * gv[bj][0], v1 = acc[ai][bj][m][1] * gv[bj][1];
                    u32x4 w; w.x = cvt_pk_bf16(v0[0], v0[1]); w.y = cvt_pk_bf16(v0[2], v0[3]); w.z = cvt_pk_bf16(v1[0], v1[1]); w.w = cvt_pk_bf16(v1[2], v1[3]);
                    *(u32x4*)(rowp + bj * HALF) = w; } }
    }
};

__device__ __forceinline__ void cons_pref_direct(const float* ssq, const float* sw, int N, const Unit& u, LAS float* tab, int tid) {
    const f32x4 part = *(const f32x4*)(ssq + ((size_t)u.pm * BM + (tid >> 1)) * 8 + (tid & 1) * 4);
    const float s_ = add_xor1((part.x + part.y) + (part.z + part.w));
    if ((tid & 1) == 0) tab[tid >> 1] = 1.0f / sqrtf(s_ * (1.0f / DM) + EPS);
    if (tid < 64) *(LAS f32x4*)(tab + 256 + tid * 4) = *(const f32x4*)(sw + (size_t)ci_of_pm(u.pm) * N + u.pn * BM + tid * 4);
}
__device__ __forceinline__ void cons_pref_dma(const float* ssq, const float* sw, int N, const Unit& u, LAS float* stg, int wid, int lane) {
    __builtin_amdgcn_global_load_lds((const unsigned*)(ssq + ((size_t)u.pm * BM + wid * 32) * 8 + lane * 4), (LAS unsigned*)(stg + wid * 256), 16, 0, 0);
    __builtin_amdgcn_global_load_lds((const unsigned*)(sw + (size_t)ci_of_pm(u.pm) * N + u.pn * BM + lane * 4), (LAS unsigned*)(stg + 2048), 16, 0, 0);
}
__device__ __forceinline__ void cons_pref_commit(const LAS float* stg, LAS float* tab, int tid) {
    const f32x4 part = *(const LAS f32x4*)(stg + (tid >> 1) * 8 + (tid & 1) * 4);
    const float s_ = add_xor1((part.x + part.y) + (part.z + part.w));
    if ((tid & 1) == 0) tab[tid >> 1] = 1.0f / sqrtf(s_ * (1.0f / DM) + EPS);
    if (tid < 64) *(LAS f32x4*)(tab + 256 + tid * 4) = *(const LAS f32x4*)(stg + 2048 + tid * 4);
}

struct EpiSwiglu {
    static constexpr bool PERM = true, HAS_PREF = true;
    bf16_t* O;
    const float* ssq;
    const float* sw;
    __device__ __forceinline__ void pref_direct(const Unit& u, LAS float* tab, int tid) const { cons_pref_direct(ssq, sw, 2 * FFH, u, tab, tid); }
    __device__ __forceinline__ void pref_dma(const Unit& u, LAS float* stg, int wid, int lane) const { cons_pref_dma(ssq, sw, 2 * FFH, u, stg, wid, lane); }
    __device__ __forceinline__ void pref_commit(const LAS float* stg, LAS float* tab, int tid) const { cons_pref_commit(stg, tab, tid); }
    __device__ __forceinline__ void post(const Unit&, const LAS float*, int) const {}
    __device__ __forceinline__ void operator()(const f32x4 (&acc)[2][2][4][2], const Unit& u, int wr, int wc, int fr, int fq, const LAS float* rt, LAS float*) const {
        bf16_t* blk = O + ((size_t)(u.pm * (FFH / 64) + 2 * u.pn + (wc >> 1)) * 256 + wr * 64 + fr) * 64 + (wc & 1) * 32 + 8 * fq;
        const LAS float* swp = rt + 256 + wc * 32 + 8 * fq;
        f32x4 sa[2], sb[2];
#pragma unroll
        for (int n = 0; n < 2; ++n) { sa[n] = *(const LAS f32x4*)(swp + 4 * n); sb[n] = *(const LAS f32x4*)(swp + HALF + 4 * n); }
#pragma unroll
        for (int ai = 0; ai < 2; ++ai)
#pragma unroll
            for (int m = 0; m < 4; ++m) { bf16_t* rowp = blk + (size_t)(ai * HALF + m * 16) * 64; const float rs = rt[ai * HALF + wr * 64 + m * 16 + fr];
                f32x4 r[2];
#pragma unroll
                for (int n = 0; n < 2; ++n) {
                    const f32x4 a = acc[ai][0][m][n] * rs + sa[n], b = acc[ai][1][m][n] * rs + sb[n];
                    const f32x4 e = a * -1.4426950408889634f;
                    f32x4 d; d.x = __builtin_amdgcn_exp2f(e.x); d.y = __builtin_amdgcn_exp2f(e.y); d.z = __builtin_amdgcn_exp2f(e.z); d.w = __builtin_amdgcn_exp2f(e.w);
                    d = d + 1.0f;
                    f32x4 sg; sg.x = __builtin_amdgcn_rcpf(d.x); sg.y = __builtin_amdgcn_rcpf(d.y); sg.z = __builtin_amdgcn_rcpf(d.z); sg.w = __builtin_amdgcn_rcpf(d.w);
                    r[n] = (a * b) * sg; }
                u32x4 w; w.x = cvt_pk_bf16(r[0].x, r[0].y); w.y = cvt_pk_bf16(r[0].z, r[0].w); w.z = cvt_pk_bf16(r[1].x, r[1].y); w.w = cvt_pk_bf16(r[1].z, r[1].w);
                *(u32x4*)rowp = w; }
    }
};

struct EpiGelu {
    static constexpr bool PERM = true, HAS_PREF = true;
    bf16_t* Z; float* vss; const float* ssq; const float* sw;
    __device__ __forceinline__ void pref_direct(const Unit& u, LAS float* tab, int tid) const { cons_pref_direct(ssq, sw, 4096, u, tab, tid); }
    __device__ __forceinline__ void pref_dma(const Unit& u, LAS float* stg, int wid, int lane) const { cons_pref_dma(ssq, sw, 4096, u, stg, wid, lane); }
    __device__ __forceinline__ void pref_commit(const LAS float* stg, LAS float* tab, int tid) const { cons_pref_commit(stg, tab, tid); }
    __device__ __forceinline__ void post(const Unit&, const LAS float*, int) const {}
    __device__ __forceinline__ void operator()(const f32x4 (&acc)[2][2][4][2], const Unit& u, int wr, int wc, int fr, int fq, const LAS float* rt, LAS float*) const {
        const int row0 = u.pm * BM + wr * 64 + fr, col0 = u.pn * BM + wc * 32 + 8 * fq;
        const LAS float* swp = rt + 256 + wc * 32 + 8 * fq;
        f32x4 sv[2][2];
#pragma unroll
        for (int bj = 0; bj < 2; ++bj)
#pragma unroll
            for (int n = 0; n < 2; ++n) sv[bj][n] = *(const LAS f32x4*)(swp + bj * HALF + 4 * n);
#pragma unroll
        for (int ai = 0; ai < 2; ++ai)
#pragma unroll
            for (int m = 0; m < 4; ++m) { const int row = row0 + ai * HALF + m * 16; bf16_t* rowp = Z + (size_t)row * 4096 + col0; float ss = 0.f; const float rs = rt[ai * HALF + wr * 64 + m * 16 + fr];
#pragma unroll
                for (int bj = 0; bj < 2; ++bj) { const f32x4 v0 = acc[ai][bj][m][0] * rs + sv[bj][0], v1 = acc[ai][bj][m][1] * rs + sv[bj][1];
                    const f32x2 a = gelu_pk((f32x2){v0[0], v0[1]}), b = gelu_pk((f32x2){v0[2], v0[3]}), c = gelu_pk((f32x2){v1[0], v1[1]}), d = gelu_pk((f32x2){v1[2], v1[3]});
                    ss += (a.x * a.x + a.y * a.y) + (b.x * b.x + b.y * b.y) + (c.x * c.x + c.y * c.y) + (d.x * d.x + d.y * d.y);
                    u32x4 w; w.x = cvt_pk_bf16(a.x, a.y); w.y = cvt_pk_bf16(b.x, b.y); w.z = cvt_pk_bf16(c.x, c.y); w.w = cvt_pk_bf16(d.x, d.y);
                    *(u32x4*)(rowp + bj * HALF) = w; }
                if (u.pn >= 8) { ss = add_xor16(ss); ss = add_xor32(ss); if (fq == 0) vss[(size_t)row * 32 + (u.pn - 8) * 4 + wc] = ss; } }
    }
};

struct EpiQKV {
    static constexpr bool PERM = true, HAS_PREF = true;
    bf16_t *Q, *Kall, *Vall, *Kc, *Vc; float *outk, *outv; const float* rope;
    const float* ssq; const float* sw;
    __device__ __forceinline__ void pref_direct(const Unit& u, LAS float* tab, int tid) const { cons_pref_direct(ssq, sw, 6144, u, tab, tid); }
    __device__ __forceinline__ void pref_dma(const Unit& u, LAS float* stg, int wid, int lane) const { cons_pref_dma(ssq, sw, 6144, u, stg, wid, lane); }
    __device__ __forceinline__ void pref_commit(const LAS float* stg, LAS float* tab, int tid) const { cons_pref_commit(stg, tab, tid); }
    __device__ __forceinline__ void post(const Unit&, const LAS float*, int) const {}
    __device__ __forceinline__ void operator()(f32x4 (&acc)[2][2][4][2], const Unit& u, int wr, int wc, int fr, int fq, const LAS float* rt, LAS float*) const {
        { const LAS float* swp = rt + 256 + wc * 32 + 8 * fq;
          f32x4 sv[2][2];
#pragma unroll
          for (int bj = 0; bj < 2; ++bj)
#pragma unroll
              for (int n = 0; n < 2; ++n) sv[bj][n] = *(const LAS f32x4*)(swp + bj * HALF + 4 * n);
#pragma unroll
          for (int ai = 0; ai < 2; ++ai)
#pragma unroll
              for (int m = 0; m < 4; ++m) { const float rs = rt[ai * HALF + wr * 64 + m * 16 + fr];
#pragma unroll
                  for (int bj = 0; bj < 2; ++bj)
#pragma unroll
                      for (int n = 0; n < 2; ++n) acc[ai][bj][m][n] = acc[ai][bj][m][n] * rs + sv[bj][n]; } }
        const bool ctx = u.pm < 32;
        const int row0 = u.pm * BM + wr * 64 + fr;
        const int lb = ctx ? 0 : ((u.pm - 32) >> 4);
        if (u.pn < 16) {
            const int sec = u.pn >> 3, h = u.pn & 7, mp = wc >> 1, axis = wc & 1;
            const int nat0 = h * 256 + mp * 128 + axis * 64 + 8 * fq;
            if (ctx) {
                bf16_t* dst = sec ? Kc : Q;
#pragma unroll
                for (int ai = 0; ai < 2; ++ai)
#pragma unroll
                    for (int m = 0; m < 4; ++m) { const int row = row0 + ai * HALF + m * 16;
#pragma unroll
                        for (int bj = 0; bj < 2; ++bj) { const f32x4 v0 = acc[ai][bj][m][0], v1 = acc[ai][bj][m][1]; const size_t o = (size_t)row * DM + nat0 + bj * 32;
                            u32x4 w; w.x = cvt_pk_bf16(v0[0], v0[1]); w.y = cvt_pk_bf16(v0[2], v0[3]); w.z = cvt_pk_bf16(v1[0], v1[1]); w.w = cvt_pk_bf16(v1[2], v1[3]);
                            *(u32x4*)(dst + o) = w;
                            if (sec) { *(f32x4*)(outk + o) = v0; *(f32x4*)(outk + o + 4) = v1; } } }
            } else {
#pragma unroll
                for (int am = 0; am < 4; ++am) { const int ai = am >> 1, mb = (am & 1) * 2;
                    f32x4 cs[2][4];
#pragma unroll
                    for (int m_ = 0; m_ < 2; ++m_) { const int row = row0 + ai * HALF + (mb + m_) * 16; const int t = (row - NCTX) & (LATSEQ - 1); const int pos = axis ? (t & 63) : (t >> 6);
                        const f32x4* rp = (const f32x4*)(rope + (size_t)(pos * 32 + 8 * fq) * 2);
#pragma unroll
                        for (int j = 0; j < 4; ++j) cs[m_][j] = rp[j]; }
#pragma unroll
                    for (int m_ = 0; m_ < 2; ++m_) { const int m = mb + m_; const int row = row0 + ai * HALF + m * 16; const int t = (row - NCTX) & (LATSEQ - 1);
                        const float cc[8] = {cs[m_][0][0], cs[m_][0][2], cs[m_][1][0], cs[m_][1][2], cs[m_][2][0], cs[m_][2][2], cs[m_][3][0], cs[m_][3][2]};
                        const float sn[8] = {cs[m_][0][1], cs[m_][0][3], cs[m_][1][1], cs[m_][1][3], cs[m_][2][1], cs[m_][2][3], cs[m_][3][1], cs[m_][3][3]};
                        float o1[8], o2[8];
#pragma unroll
                        for (int n = 0; n < 2; ++n)
#pragma unroll
                            for (int i = 0; i < 4; ++i) { const float x1 = acc[ai][0][m][n][i], x2 = acc[ai][1][m][n][i]; const float c = cc[n * 4 + i], sv = sn[n * 4 + i];
                                o1[n * 4 + i] = x1 * c - x2 * sv; o2[n * 4 + i] = x2 * c + x1 * sv; }
                        bf16_t* dp = sec ? (Kall + ((size_t)lb * KVLEN + PAST + t) * DM + nat0) : (Q + (size_t)row * DM + nat0);
                        u32x4 w; w.x = cvt_pk_bf16(o1[0], o1[1]); w.y = cvt_pk_bf16(o1[2], o1[3]); w.z = cvt_pk_bf16(o1[4], o1[5]); w.w = cvt_pk_bf16(o1[6], o1[7]);
                        *(u32x4*)dp = w;
                        w.x = cvt_pk_bf16(o2[0], o2[1]); w.y = cvt_pk_bf16(o2[2], o2[3]); w.z = cvt_pk_bf16(o2[4], o2[5]); w.w = cvt_pk_bf16(o2[6], o2[7]);
                        *(u32x4*)(dp + 32) = w; }
                }
            }
        } else {
            const int col0 = (u.pn - 16) * BM + wc * 32 + 8 * fq;
#pragma unroll
            for (int ai = 0; ai < 2; ++ai)
#pragma unroll
                for (int m = 0; m < 4; ++m) { const int row = row0 + ai * HALF + m * 16; const int t = (row - NCTX) & (LATSEQ - 1);
                    bf16_t* dp = ctx ? (Vc + (size_t)row * DM + col0) : (Vall + ((size_t)lb * KVLEN + PAST + t) * DM + col0);
#pragma unroll
                    for (int bj = 0; bj < 2; ++bj) { const f32x4 v0 = acc[ai][bj][m][0], v1 = acc[ai][bj][m][1];
                        u32x4 w; w.x = cvt_pk_bf16(v0[0], v0[1]); w.y = cvt_pk_bf16(v0[2], v0[3]); w.z = cvt_pk_bf16(v1[0], v1[1]); w.w = cvt_pk_bf16(v1[2], v1[3]);
                        *(u32x4*)(dp + bj * HALF) = w;
                        if (ctx) { float* op = outv + (size_t)row * DM + col0 + bj * HALF; *(f32x4*)op = v0; *(f32x4*)(op + 4) = v1; } } }
        }
    }
};

template <class Epi, class Sched>
__device__ __forceinline__ void gemm_phase(LAS unsigned char* lds, const Gemm g, const Sched& S, const Epi& E) {
    const int tid = opaque_tid(), wid = __builtin_amdgcn_readfirstlane(tid >> 6), lane = tid & 63, wr = wid >> 2, wc = wid & 3, fr = lane & 15, fq = lane >> 4;
    const int K = g.K, nt = K / BK, lda = g.lda;
    unsigned voffA[2], voffB[2];
#pragma unroll
    for (int i = 0; i < 2; ++i) { int R, C; stage_rc(tid * 16 + i * 8192, R, C); const int Rb = Epi::PERM ? ((R & ~31) + perm32(R & 31)) : R;
        voffA[i] = (unsigned)(R * lda + C) * 2u; voffB[i] = (unsigned)(Rb * K + C) * 2u; }
    const size_t kstep = (size_t)(BK * 2), kstepA = g.kstepA;
    const size_t hstepA = (size_t)HALF * lda * 2, hstepB = (size_t)HALF * K * 2;
    const unsigned ldsw = (unsigned)wid * 1024u;
    const int aoff = lds_byte(wr * 64 + fr, fq * 8), boff = lds_byte(wc * 32 + fr, fq * 8);
#define PG8_SA(b, h) (((b) * 2 + (h)) * HTB)
#define PG8_SB(b, h) ((4 + (b) * 2 + (h)) * HTB)
#define PG8_STAGE(bufoff, gbase, voff) do { _Pragma("unroll") for (int _i = 0; _i < 2; ++_i) \
        __builtin_amdgcn_global_load_lds((const unsigned*)((const char*)(gbase) + (voff)[_i]), (LAS unsigned*)(lds + (bufoff) + ldsw + _i * 8192), 16, 0, 0); } while (0)
#define PG8_LDA(dst, b, h) do { _Pragma("unroll") for (int m = 0; m < 4; ++m) _Pragma("unroll") for (int k = 0; k < 2; ++k) dst[m][k] = *(const LAS bf16x8*)(lds + PG8_SA(b, h) + aoff + m * 2048 + k * 1024); } while (0)
#define PG8_LDB(dst, b, h) do { _Pragma("unroll") for (int n = 0; n < 2; ++n) _Pragma("unroll") for (int k = 0; k < 2; ++k) dst[n][k] = *(const LAS bf16x8*)(lds + PG8_SB(b, h) + boff + n * 2048 + k * 1024); } while (0)
#define PG8_MMA(ai, bj, At, Bt) do { __builtin_amdgcn_s_setprio(1); _Pragma("unroll") for (int m = 0; m < 4; ++m) _Pragma("unroll") for (int n = 0; n < 2; ++n) _Pragma("unroll") for (int k = 0; k < 2; ++k) \
        acc[ai][bj][m][n] = __builtin_amdgcn_mfma_f32_16x16x32_bf16(Bt[n][k], At[m][k], acc[ai][bj][m][n], 0, 0, 0); __builtin_amdgcn_s_setprio(0); } while (0)
#define PG8_WAIT_V(n) asm volatile("s_waitcnt vmcnt(" #n ")" ::: "memory")
#define PG8_WAIT_L(n) asm volatile("s_waitcnt lgkmcnt(" #n ")" ::: "memory")
#define PG8_BAR __builtin_amdgcn_s_barrier()
#define PG8_SCHED __builtin_amdgcn_sched_barrier(0)
    Unit cur, nxt, prv; int ui = 0;
    if (!S.next(0, cur)) return;
    prv = cur;
    LAS float* TAB = (LAS float*)(lds + RT_OFF);
    LAS float* STG = TAB + STG_FLOAT_OFF;
    if constexpr (Epi::HAS_PREF) E.pref_direct(cur, TAB, tid);
    f32x4 acc[2][2][4][2];
#pragma unroll
    for (int a = 0; a < 2; ++a)
#pragma unroll
        for (int b = 0; b < 2; ++b)
#pragma unroll
            for (int m = 0; m < 4; ++m)
#pragma unroll
                for (int n = 0; n < 2; ++n) acc[a][b][m][n] = (f32x4){0.f, 0.f, 0.f, 0.f};
    bf16x8 At[4][2], B0[2][2], B1[2][2];
    const char* cA = (const char*)g.A + (size_t)cur.pm * g.tstepA + (size_t)(cur.pn >> 1) * g.agrp * 2; const char* cB = (const char*)g.Bt + (size_t)cur.pn * 2 * hstepB;
    PG8_STAGE(PG8_SB(0, 0), cB, voffB); PG8_STAGE(PG8_SB(0, 1), cB + hstepB, voffB); PG8_STAGE(PG8_SA(0, 0), cA, voffA); PG8_STAGE(PG8_SA(0, 1), cA + hstepA, voffA);
    if (wr == 1) PG8_BAR;
    PG8_WAIT_V(2); PG8_BAR;
    PG8_STAGE(PG8_SB(1, 0), cB + kstep, voffB); PG8_STAGE(PG8_SA(1, 0), cA + kstepA, voffA); PG8_STAGE(PG8_SB(1, 1), cB + hstepB + kstep, voffB);
    PG8_WAIT_V(6); PG8_BAR;
    for (;;) {
        const bool has_next = S.next(ui + 1, nxt);
        const char* nA = has_next ? (const char*)g.A + (size_t)nxt.pm * g.tstepA + (size_t)(nxt.pn >> 1) * g.agrp * 2 : cA; const char* nB = has_next ? (const char*)g.Bt + (size_t)nxt.pn * 2 * hstepB : cB;
        for (int t = 0; t < nt; t += 2) {
            const bool last = (t == nt - 2);
            if constexpr (Epi::HAS_PREF) { if (last && has_next) E.pref_dma(nxt, STG, wid, lane); }
            const char* a1 = cA + (size_t)(t + 1) * kstepA;
            const char* a2 = last ? nA : cA + (size_t)(t + 2) * kstepA; const char* b2 = last ? nB : cB + (size_t)(t + 2) * kstep;
            const char* a3 = a2 + kstepA; const char* b3 = b2 + kstep;
            PG8_LDB(B0, 0, 0); PG8_LDB(B1, 0, 1); PG8_SCHED; PG8_LDA(At, 0, 0); PG8_STAGE(PG8_SA(1, 1), a1 + hstepA, voffA);
            PG8_WAIT_V(8); PG8_WAIT_L(0); PG8_BAR; PG8_MMA(0, 0, At, B0); PG8_MMA(0, 1, At, B1); PG8_BAR; PG8_SCHED;
            PG8_LDA(At, 0, 1); PG8_STAGE(PG8_SB(0, 0), b2, voffB); PG8_STAGE(PG8_SB(0, 1), b2 + hstepB, voffB); PG8_STAGE(PG8_SA(0, 0), a2, voffA);
            PG8_WAIT_V(8); PG8_WAIT_L(0); PG8_BAR; PG8_MMA(1, 0, At, B0); PG8_MMA(1, 1, At, B1); PG8_BAR; PG8_SCHED;
            PG8_LDB(B0, 1, 0); PG8_LDB(B1, 1, 1); PG8_SCHED; PG8_LDA(At, 1, 0); PG8_STAGE(PG8_SA(0, 1), a2 + hstepA, voffA);
            PG8_WAIT_V(8); PG8_WAIT_L(0); PG8_BAR; PG8_MMA(0, 0, At, B0); PG8_MMA(0, 1, At, B1); PG8_BAR; PG8_SCHED;
            PG8_LDA(At, 1, 1); PG8_STAGE(PG8_SB(1, 0), b3, voffB); PG8_STAGE(PG8_SB(1, 1), b3 + hstepB, voffB); PG8_STAGE(PG8_SA(1, 0), a3, voffA);
            PG8_WAIT_V(8); PG8_WAIT_L(0); PG8_BAR; PG8_MMA(1, 0, At, B0); PG8_MMA(1, 1, At, B1); PG8_BAR; PG8_SCHED;
        }
        if (wr == 0) PG8_BAR;
        if (ui > 0) E.post(prv, TAB + 2 * TAB_FLOATS + ((ui - 1) & 1) * SSX_FLOATS, tid);
        E(acc, cur, wr, wc, fr, fq, TAB + (ui & 1) * TAB_FLOATS, TAB + 2 * TAB_FLOATS + (ui & 1) * SSX_FLOATS);
        prv = cur;
        if (!has_next) break;
        if constexpr (Epi::HAS_PREF) E.pref_commit(STG, TAB + ((ui + 1) & 1) * TAB_FLOATS, tid);
#pragma unroll
        for (int a = 0; a < 2; ++a)
#pragma unroll
            for (int b = 0; b < 2; ++b)
#pragma unroll
                for (int m = 0; m < 4; ++m)
#pragma unroll
                    for (int n = 0; n < 2; ++n) acc[a][b][m][n] = (f32x4){0.f, 0.f, 0.f, 0.f};
        cur = nxt; cA = nA; cB = nB; ++ui;
        if (wr == 1) PG8_BAR;
    }
    PG8_WAIT_V(0);
    PG8_WAIT_L(0); PG8_BAR; asm volatile("" ::: "memory");
    E.post(prv, TAB + 2 * TAB_FLOATS + (ui & 1) * SSX_FLOATS, tid);
#undef PG8_SA
#undef PG8_SB
#undef PG8_STAGE
#undef PG8_LDA
#undef PG8_LDB
#undef PG8_MMA
#undef PG8_WAIT_V
#undef PG8_WAIT_L
#undef PG8_BAR
#undef PG8_SCHED
}
}

namespace att {
constexpr int D = 128, NW = 8, QBLK = 32, KVBLK = 64;
constexpr float SCALE = 0.088388347648318440f;
constexpr float THR = 8.f;
constexpr int LDQ = DM, LDK = DM;
constexpr size_t SHM_V = KVBLK * D * 2, SHM_K = KVBLK * D * 2, SHM_ATTN = 2 * SHM_V + 2 * SHM_K + NW * 64 * 4;
#define KSWZ(row, colB) ((row) * 256 + ((colB) ^ (((row) & 7) << 4)))
#define SBAR() __builtin_amdgcn_sched_barrier(0)
__device__ __forceinline__ int crow(int r, int hi) { return (r & 3) + 8 * (r >> 2) + 4 * hi; }
__device__ __forceinline__ unsigned cvtpk(float lo, float hi) { unsigned r; asm volatile("v_cvt_pk_bf16_f32 %0, %1, %2" : "=v"(r) : "v"(lo), "v"(hi)); return r; }
__device__ __forceinline__ void partialSM(f32x16& p0, f32x16& p1, float& m_reg, float& mn, float& alpha) {
  constexpr float C = SCALE * 1.4426950408889634f;
  float pmax = p0[0];
#pragma unroll
  for (int r = 1; r < 16; ++r) pmax = fmaxf(pmax, p0[r]);
#pragma unroll
  for (int r = 0; r < 16; ++r) pmax = fmaxf(pmax, p1[r]);
  { auto rr = __builtin_amdgcn_permlane32_swap(__float_as_uint(pmax), __float_as_uint(pmax), false, false);
    pmax = fmaxf(__uint_as_float(rr[0]), __uint_as_float(rr[1])); }
  if (__builtin_expect(__all(pmax - m_reg <= THR / SCALE), 1)) { mn = m_reg; alpha = 1.f; }
  else { mn = fmaxf(m_reg, pmax); alpha = __builtin_amdgcn_exp2f((m_reg - mn) * C); m_reg = mn; }
  float mnC = -mn * C;
#pragma unroll
  for (int r = 0; r < 16; ++r) p0[r] = fmaf(p0[r], C, mnC);
#pragma unroll
  for (int r = 0; r < 16; ++r) p1[r] = fmaf(p1[r], C, mnC);
#pragma unroll
  for (int r = 0; r < 16; ++r) p0[r] = __builtin_amdgcn_exp2f(p0[r]);
}
__device__ __forceinline__ void finishSM(f32x16& p0, f32x16& p1, float alpha, float& l_reg, bf16x8& pa0, bf16x8& pa1, bf16x8& pa2, bf16x8& pa3) {
#pragma unroll
  for (int r = 0; r < 16; ++r) p1[r] = __builtin_amdgcn_exp2f(p1[r]);
  float ps = 0;
#pragma unroll
  for (int r = 0; r < 16; ++r) ps += p0[r];
#pragma unroll
  for (int r = 0; r < 16; ++r) ps += p1[r];
  { auto rr = __builtin_amdgcn_permlane32_swap(__float_as_uint(ps), __float_as_uint(ps), false, false);
    ps = __uint_as_float(rr[0]) + __uint_as_float(rr[1]); }
  l_reg = l_reg * alpha + ps;
#define PK4(P, BASE, OUT) do { unsigned a0 = cvtpk(P[BASE + 0], P[BASE + 1]), a1 = cvtpk(P[BASE + 2], P[BASE + 3]);   \
    unsigned b0 = cvtpk(P[BASE + 4], P[BASE + 5]), b1 = cvtpk(P[BASE + 6], P[BASE + 7]);                              \
    auto r0 = __builtin_amdgcn_permlane32_swap(a0, b0, false, false); auto r1 = __builtin_amdgcn_permlane32_swap(a1, b1, false, false); \
    u32x4 w = {r0[0], r1[0], r0[1], r1[1]}; OUT = *reinterpret_cast<bf16x8*>(&w); } while (0)
  PK4(p0, 0, pa0); PK4(p0, 8, pa1); PK4(p1, 0, pa2); PK4(p1, 8, pa3);
#undef PK4
}
__device__ __forceinline__ void qkt(f32x16& p0, f32x16& p1, const bf16_t* Ks, const bf16x8* qr, int r32, int hi) {
  p0 = f32x16{}; p1 = f32x16{};
#pragma unroll
  for (int d0 = 0; d0 < 8; ++d0) { int cb = (d0 * 16 + hi * 8) * 2;
    bf16x8 b0 = *reinterpret_cast<const bf16x8*>((const char*)Ks + KSWZ(r32, cb));
    bf16x8 b1 = *reinterpret_cast<const bf16x8*>((const char*)Ks + KSWZ(32 + r32, cb));
    p0 = __builtin_amdgcn_mfma_f32_32x32x16_bf16(b0, qr[d0], p0, 0, 0, 0);
    p1 = __builtin_amdgcn_mfma_f32_32x32x16_bf16(b1, qr[d0], p1, 0, 0, 0); }
}
__device__ __forceinline__ int v_st(int k, int c) { const int kk = (k & ~0xC) | ((k & 4) << 1) | ((k & 8) >> 1); return ((kk >> 3) * 4 + (c >> 5)) * 512 + ((kk & 7) * 32 + (c & 31)) * 2; }
__device__ __forceinline__ int v_rd_base(int lane) { return ((lane & 3) << 3) | (((lane >> 2) & 3) << 6) | (((lane >> 4) & 1) << 5) | (((lane >> 5) & 1) << 8); }
constexpr int v_rd_off(int d0, int ks, int half) { return d0 * 512 + ks * 4096 + half * 2048; }
template <int OFF> __device__ __forceinline__ s16x4 tr_read(int vb) {
  s16x4 r; asm volatile("ds_read_b64_tr_b16 %0, %1 offset:%2" : "=&v"(r) : "v"(vb), "i"(OFF) : "memory"); return r;
}
template <int D0> __device__ __forceinline__ void pv_one(f32x16& od, int vb, bf16x8 pa0, bf16x8 pa1, bf16x8 pa2, bf16x8 pa3) {
  const s16x4 l0 = tr_read<v_rd_off(D0, 0, 0)>(vb), h0 = tr_read<v_rd_off(D0, 0, 1)>(vb), l1 = tr_read<v_rd_off(D0, 1, 0)>(vb), h1 = tr_read<v_rd_off(D0, 1, 1)>(vb);
  const s16x4 l2 = tr_read<v_rd_off(D0, 2, 0)>(vb), h2 = tr_read<v_rd_off(D0, 2, 1)>(vb), l3 = tr_read<v_rd_off(D0, 3, 0)>(vb), h3 = tr_read<v_rd_off(D0, 3, 1)>(vb);
  asm volatile("s_waitcnt lgkmcnt(0)" ::: "memory"); SBAR();
#define PK(L, H) (bf16x8){L[0], L[1], L[2], L[3], H[0], H[1], H[2], H[3]}
  od = __builtin_amdgcn_mfma_f32_32x32x16_bf16(pa0, PK(l0, h0), od, 0, 0, 0);
  od = __builtin_amdgcn_mfma_f32_32x32x16_bf16(pa1, PK(l1, h1), od, 0, 0, 0);
  od = __builtin_amdgcn_mfma_f32_32x32x16_bf16(pa2, PK(l2, h2), od, 0, 0, 0);
  od = __builtin_amdgcn_mfma_f32_32x32x16_bf16(pa3, PK(l3, h3), od, 0, 0, 0);
#undef PK
}
__device__ __forceinline__ void pv_d0(f32x16* o, int vb, bf16x8 pa0, bf16x8 pa1, bf16x8 pa2, bf16x8 pa3) {
  pv_one<0>(o[0], vb, pa0, pa1, pa2, pa3); pv_one<1>(o[1], vb, pa0, pa1, pa2, pa3); pv_one<2>(o[2], vb, pa0, pa1, pa2, pa3); pv_one<3>(o[3], vb, pa0, pa1, pa2, pa3);
}

__device__ __forceinline__ void attn_pass(const bf16_t* __restrict__ Qb, const bf16_t* __restrict__ Kh, const bf16_t* __restrict__ Vh, int seq, char* lds, f32x16 (&o)[4]) {
  const int tid = opaque_tid(), wid = tid >> 6, lane = tid & 63, r32 = lane & 31, hi = lane >> 5;
  bf16_t* V_lds = (bf16_t*)lds; bf16_t* K_lds = (bf16_t*)(lds + 2 * SHM_V);
  float* ws = (float*)(lds + 2 * SHM_V + 2 * SHM_K) + wid * 64; float* li_l = ws; float* al_l = ws + 32;
  float m_reg = -1e30f, l_reg = 0; bf16x8 qr[8];
#pragma unroll
  for (int d = 0; d < 4; ++d) o[d] = f32x16{};
  const bf16_t* Qw = Qb + (long)(wid * QBLK + r32) * LDQ + hi * 8;
#pragma unroll
  for (int d0 = 0; d0 < 8; ++d0) qr[d0] = *reinterpret_cast<const bf16x8*>(Qw + d0 * 16);
  const int sr = tid >> 4, sc = (tid & 15) * 8, vst0 = v_st(sr, sc), vst1 = v_st(32 + sr, sc);
  const int vb0 = (int)(uintptr_t)V_lds + v_rd_base(lane);
  struct { bf16x8 vs0, vs1, ks0, ks1; } sr_[1];
#define SLOAD(i, k0) do { sr_[i].vs0 = *reinterpret_cast<const bf16x8*>(&Vh[(long)((k0) + sr) * LDK + sc]); sr_[i].vs1 = *reinterpret_cast<const bf16x8*>(&Vh[(long)((k0) + 32 + sr) * LDK + sc]); \
    sr_[i].ks0 = *reinterpret_cast<const bf16x8*>(&Kh[(long)((k0) + sr) * LDK + sc]); sr_[i].ks1 = *reinterpret_cast<const bf16x8*>(&Kh[(long)((k0) + 32 + sr) * LDK + sc]); } while (0)
#define SWRITE(b, i) do { *(bf16x8*)((char*)V_lds + (b) * SHM_V + vst0) = sr_[i].vs0;          \
    *(bf16x8*)((char*)V_lds + (b) * SHM_V + vst1) = sr_[i].vs1; int kc = sc * 2;               \
    *(bf16x8*)((char*)K_lds + (b) * SHM_K + KSWZ(sr, kc)) = sr_[i].ks0;                       \
    *(bf16x8*)((char*)K_lds + (b) * SHM_K + KSWZ(32 + sr, kc)) = sr_[i].ks1; } while (0)
#define SWAIT() asm volatile("s_waitcnt vmcnt(0)" ::: "memory")
#define RESC(a) do { if (__any((a) < 1.f)) { if (hi == 0) al_l[r32] = (a); asm volatile("s_waitcnt lgkmcnt(0)" ::: "memory"); \
    _Pragma("unroll") for (int d = 0; d < 4; ++d) _Pragma("unroll") for (int r = 0; r < 16; ++r) o[d][r] *= al_l[crow(r, hi)]; } } while (0)
  f32x16 pA0, pA1, pB0, pB1; float mnA, mnB, alA, alB; bf16x8 pa0, pa1, pa2, pa3; const int NT = seq / KVBLK;
  constexpr int SE = 0, SO = 0;
  SLOAD(SE, 0); asm volatile("s_waitcnt vmcnt(0)" ::: "memory"); SWRITE(0, SE); __syncthreads();
  qkt(pA0, pA1, K_lds, qr, r32, hi); partialSM(pA0, pA1, m_reg, mnA, alA);
  SLOAD(SO, KVBLK);
  SWAIT(); SWRITE(1, SO); __syncthreads();
  for (int j = 1; j + 1 < NT; j += 2) {
    SBAR(); qkt(pB0, pB1, (bf16_t*)((char*)K_lds + SHM_K), qr, r32, hi);
    finishSM(pA0, pA1, alA, l_reg, pa0, pa1, pa2, pa3); SBAR();
    SLOAD(SO, (j + 1) * KVBLK); SBAR();
    pv_d0(o, vb0, pa0, pa1, pa2, pa3); partialSM(pB0, pB1, m_reg, mnB, alB);
    __syncthreads(); SWAIT(); SWRITE(0, SE);
    RESC(alB); __syncthreads();
    SBAR(); qkt(pA0, pA1, K_lds, qr, r32, hi);
    finishSM(pB0, pB1, alB, l_reg, pa0, pa1, pa2, pa3); SBAR();
    SLOAD(SE, (j + 2) * KVBLK); SBAR();
    pv_d0(o, vb0 + (int)SHM_V, pa0, pa1, pa2, pa3); partialSM(pA0, pA1, m_reg, mnA, alA);
    __syncthreads(); SWAIT(); SWRITE(1, SO);
    RESC(alA); __syncthreads();
  }
  SBAR(); qkt(pB0, pB1, (bf16_t*)((char*)K_lds + SHM_K), qr, r32, hi);
  finishSM(pA0, pA1, alA, l_reg, pa0, pa1, pa2, pa3); SBAR();
  pv_d0(o, vb0, pa0, pa1, pa2, pa3); partialSM(pB0, pB1, m_reg, mnB, alB);
  __syncthreads(); RESC(alB);
  finishSM(pB0, pB1, alB, l_reg, pa0, pa1, pa2, pa3); SBAR();
  pv_d0(o, vb0 + (int)SHM_V, pa0, pa1, pa2, pa3);
  if (hi == 0) li_l[r32] = l_reg; asm volatile("s_waitcnt lgkmcnt(0)" ::: "memory");
#pragma unroll
  for (int r = 0; r < 16; ++r) { const float rl = __builtin_amdgcn_rcpf(li_l[crow(r, hi)]);
#pragma unroll
    for (int d0 = 0; d0 < 4; ++d0) o[d0][r] *= rl; }
  __syncthreads();
#undef SLOAD
#undef SWRITE
#undef SWAIT
#undef RESC
}

#define ABAR() do { asm volatile("" ::: "memory"); __builtin_amdgcn_s_barrier(); asm volatile("" ::: "memory"); __builtin_amdgcn_sched_barrier(0); } while (0)
__device__ __forceinline__ void qkt_l(f32x16& p0, f32x16& p1, const LAS char* Ks, const bf16x8* qr, int r32, int hi) {
  p0 = f32x16{}; p1 = f32x16{};
#pragma unroll
  for (int d0 = 0; d0 < 8; ++d0) { const int cb = (d0 * 16 + hi * 8) * 2;
    const bf16x8 b0 = *(const LAS bf16x8*)(Ks + KSWZ(r32, cb));
    const bf16x8 b1 = *(const LAS bf16x8*)(Ks + KSWZ(32 + r32, cb));
    p0 = __builtin_amdgcn_mfma_f32_32x32x16_bf16(b0, qr[d0], p0, 0, 0, 0);
    p1 = __builtin_amdgcn_mfma_f32_32x32x16_bf16(b1, qr[d0], p1, 0, 0, 0);
    if ((d0 & 3) == 3) SBAR(); }
}
__device__ __forceinline__ void attn_pass2(const bf16_t* __restrict__ Qb, const bf16_t* __restrict__ Kh, const bf16_t* __restrict__ Vh, int seq, LAS unsigned char* lds, f32x16 (&o)[8]) {
  const int tid = opaque_tid(), wid = __builtin_amdgcn_readfirstlane(tid >> 6), lane = tid & 63, r32 = lane & 31, hi = lane >> 5;
  constexpr int KB0 = 0, VB0 = 32768, WS0 = 98304;
  LAS float* li_l = (LAS float*)(lds + WS0) + wid * 64; LAS float* al_l = li_l + 32;
  unsigned kof, vof;
  { const int q = wid * 64 + lane, row = q >> 4, cs = q & 15; kof = (unsigned)(row * LDK + ((cs ^ (row & 7)) << 3)) * 2u; }
  { const int B = (wid * 64 + lane) * 16, sub = B >> 9, within = B & 511;
    const int kk = (sub >> 2) * 8 + (within >> 6), k = (kk & ~0xC) | ((kk & 4) << 1) | ((kk & 8) >> 1), c = (sub & 3) * 32 + ((within & 63) >> 1);
    vof = (unsigned)(k * LDK + c) * 2u; }
#define DMA_TILE(buf, k0) do { const char* kb_ = (const char*)Kh + (size_t)(k0) * LDK * 2; const char* vb_ = (const char*)Vh + (size_t)(k0) * LDK * 2; \
    _Pragma("unroll") for (int i_ = 0; i_ < 2; ++i_) __builtin_amdgcn_global_load_lds((const unsigned*)(kb_ + (size_t)i_ * 32 * LDK * 2 + kof), (LAS unsigned*)(lds + KB0 + (buf) * 16384 + (wid + 8 * i_) * 1024), 16, 0, 0); \
    _Pragma("unroll") for (int i_ = 0; i_ < 4; ++i_) __builtin_amdgcn_global_load_lds((const unsigned*)(vb_ + (size_t)(i_ & 1) * 32 * LDK * 2 + (size_t)(i_ >> 1) * 256 + vof), (LAS unsigned*)(lds + VB0 + (buf) * 32768 + (wid + 8 * i_) * 1024), 16, 0, 0); } while (0)
#define RESC2(a) do { if (__any((a) < 1.f)) { if (hi == 0) al_l[r32] = (a); asm volatile("s_waitcnt lgkmcnt(0)" ::: "memory"); \
    _Pragma("unroll") for (int d = 0; d < 8; ++d) _Pragma("unroll") for (int r = 0; r < 16; ++r) o[d][r] *= al_l[crow(r, hi)]; } } while (0)
  float m_reg = -1e30f, l_reg = 0.f; bf16x8 qr[8];
#pragma unroll
  for (int d = 0; d < 8; ++d) o[d] = f32x16{};
  const bf16_t* Qw = Qb + (long)(wid * QBLK + r32) * LDQ + hi * 8;
#pragma unroll
  for (int d0 = 0; d0 < 8; ++d0) qr[d0] = *reinterpret_cast<const bf16x8*>(Qw + d0 * 16);
  const int vb0 = (int)(unsigned)(uintptr_t)(lds + VB0) + v_rd_base(lane);
  const int NT = seq / KVBLK;
  DMA_TILE(0, 0); DMA_TILE(1, KVBLK);
#define TILE(buf, j) do { \
    if ((j) + 1 < NT) asm volatile("s_waitcnt vmcnt(6)" ::: "memory"); else asm volatile("s_waitcnt vmcnt(0)" ::: "memory"); \
    ABAR(); \
    f32x16 p0, p1; float mn, alpha; bf16x8 pa0, pa1, pa2, pa3; \
    qkt_l(p0, p1, (const LAS char*)(lds + KB0 + (buf) * 16384), qr, r32, hi); \
    partialSM(p0, p1, m_reg, mn, alpha); \
    RESC2(alpha); \
    finishSM(p0, p1, alpha, l_reg, pa0, pa1, pa2, pa3); SBAR(); \
    pv_d0(o, vb0 + (buf) * 32768, pa0, pa1, pa2, pa3); pv_d0(o + 4, vb0 + (buf) * 32768 + 16384, pa0, pa1, pa2, pa3); \
    ABAR(); \
    if ((j) + 2 < NT) DMA_TILE(buf, ((j) + 2) * KVBLK); } while (0)
  for (int j = 0; j < NT; j += 2) { TILE(0, j); TILE(1, j + 1); }
  if (hi == 0) li_l[r32] = l_reg; asm volatile("s_waitcnt lgkmcnt(0)" ::: "memory");
#pragma unroll
  for (int r = 0; r < 16; ++r) { const float rl = __builtin_amdgcn_rcpf(li_l[crow(r, hi)]);
#pragma unroll
    for (int d = 0; d < 8; ++d) o[d][r] *= rl; }
#undef DMA_TILE
#undef RESC2
#undef TILE
}
}

#define XB_TMO      128
#define XB_XCNT(j)  (256  + 64 * (j))
#define XB_XSUB(j)  (1280 + 64 * (j))
#define XB_XGEN(j)  (2304 + 64 * (j))
#define XB_TOP      3328
#define XB_TOPGEN   3392
#define XCD_BAR_WORDS 3456
#define XB_SPIN_CAP (1u << 18)
__device__ __forceinline__ unsigned xb_ld(unsigned* p)              { return __hip_atomic_load(p, __ATOMIC_RELAXED, __HIP_MEMORY_SCOPE_AGENT); }
__device__ __forceinline__ unsigned xb_add(unsigned* p, unsigned v) { return __hip_atomic_fetch_add(p, v, __ATOMIC_RELAXED, __HIP_MEMORY_SCOPE_AGENT); }
__device__ __forceinline__ unsigned xb_xcc_id() { return (unsigned)__builtin_amdgcn_s_getreg((3 << 11) | 20) & 0xFu; }
#define XB_SPIN(cond, bar) do { unsigned _sp = 0; while (cond) { __builtin_amdgcn_s_sleep(1); \
    if ((++_sp & 255u) == 0u) { if (xb_ld(&(bar)[XB_TMO])) break; if (_sp > XB_SPIN_CAP) { atomicAdd(&(bar)[XB_TMO], 1u); break; } } } } while (0)
struct XcdBarrier { unsigned* bar; unsigned x; volatile LAS unsigned* st; };
__device__ __forceinline__ XcdBarrier xcd_barrier_post(unsigned* bar, volatile LAS unsigned* st) {
    XcdBarrier b; b.bar = bar; b.x = xb_xcc_id(); b.st = st;
    if (threadIdx.x == 0) (void)xb_add(&bar[XB_XCNT(b.x)], 1u);
    return b;
}
__device__ __forceinline__ void xcd_barrier_complete(unsigned* bar, unsigned x, unsigned& nloc, unsigned& nx) {
    const unsigned G = gridDim.x * gridDim.y * gridDim.z;
    unsigned sum, cnt, mine, sp = 0u;
    for (;;) {
        sum = 0u; cnt = 0u; mine = 0u;
#pragma unroll
        for (unsigned j = 0; j < 16; ++j) { const unsigned c = xb_ld(&bar[XB_XCNT(j)]); sum += c; cnt += (c > 0u) ? 1u : 0u; mine = (j == x) ? c : mine; }
        if (sum == G) break;
        __builtin_amdgcn_s_sleep(1);
        if ((++sp & 255u) == 0u) { if (xb_ld(&bar[XB_TMO])) break; if (sp > XB_SPIN_CAP) { atomicAdd(&bar[XB_TMO], 1u); break; } }
    }
    nloc = mine > 0u ? mine : 1u; nx = cnt > 0u ? cnt : 1u;
}
__device__ __forceinline__ void xcd_barrier(const XcdBarrier& b) {
    asm volatile("s_waitcnt vmcnt(0)" ::: "memory");
    __syncthreads();
    if (threadIdx.x == 0) {
        unsigned* bar = b.bar;
        __builtin_amdgcn_s_waitcnt(0);
        unsigned nloc = b.st[0], nx = b.st[1];
        if (nloc == 0u) { xcd_barrier_complete(bar, b.x, nloc, nx); b.st[0] = nloc; b.st[1] = nx; }
        const unsigned old = xb_add(&bar[XB_XSUB(b.x)], 1u);
        const unsigned gen = old / nloc;
        if (old + 1u == (gen + 1u) * nloc) {
            __builtin_amdgcn_fence(__ATOMIC_RELEASE, "agent");
            asm volatile("s_waitcnt vmcnt(0)" ::: "memory");
            const unsigned og = xb_add(&bar[XB_TOP], 1u);
            const unsigned tg = og / nx;
            if (og + 1u == (tg + 1u) * nx) xb_add(&bar[XB_TOPGEN], 1u);
            else XB_SPIN(xb_ld(&bar[XB_TOPGEN]) == tg, bar);
            __builtin_amdgcn_fence(__ATOMIC_ACQUIRE, "agent");
            xb_add(&bar[XB_XGEN(b.x)], 1u);
            asm volatile("s_waitcnt vmcnt(0)" ::: "memory");
        } else {
            XB_SPIN(xb_ld(&bar[XB_XGEN(b.x)]) == gen, bar);
            __builtin_amdgcn_fence(__ATOMIC_ACQUIRE, "agent");
            asm volatile("s_waitcnt vmcnt(0)" ::: "memory");
        }
    }
    __syncthreads();
}

template <int MODE>
__device__ __forceinline__ void rowop_phase(int G, int bx, const float* x0, const float* x1, const float* g, const float* shiftp, const float* scalep,
                                            float* rstd_out, bf16_t* hout, float* fout) {
    const int tid = opaque_tid(), wave = __builtin_amdgcn_readfirstlane(tid >> 6), lane = tid & 63;
    const int NWV = G * 8, gw = bx * 8 + wave, rpw = (MROWS + NWV - 1) / NWV;
    const int r0 = gw * rpw, r1 = (r0 + rpw < MROWS) ? r0 + rpw : MROWS;
    f32x4 gp[8], sh[8]; int cur_ci = -1;
    if (MODE == 2) {
#pragma unroll
        for (int j = 0; j < 8; ++j) gp[j] = ((const f32x4*)g)[lane + 64 * j];
    }
    for (int row = r0; row < r1; ++row) {
        const float* xr = row < NCTX ? x0 + (size_t)row * DM : x1 + (size_t)(row - NCTX) * DM;
        f32x4 v[8]; float s = 0.f;
        if (MODE == 2) {
            const u32x2* xr16 = (const u32x2*)((const bf16_t*)x0 + (size_t)row * DM) + lane; const u32x2* dr = (const u32x2*)(hout + (size_t)row * DM) + lane;
#pragma unroll
            for (int j = 0; j < 8; ++j) { v[j] = h4_to_f4(xr16[64 * j]) + bf4_to_f4(dr[64 * j]); s += dot4(v[j]); }
        } else {
#pragma unroll
        for (int j = 0; j < 8; ++j) { v[j] = ((const f32x4*)xr)[lane + 64 * j]; s += dot4(v[j]); }
        }
        s = wave_sum(s);
        const float rs = 1.0f / sqrtf(s * (1.0f / DM) + EPS);
        if (MODE == 0) { if (lane == 0) rstd_out[row] = rs; continue; }
        if (MODE == 1) {
            const int ci = row < NCTX ? 8 : ((row - NCTX) >> 12);
            if (ci != cur_ci) { cur_ci = ci;
#pragma unroll
                for (int j = 0; j < 8; ++j) { const f32x4 gg = ((const f32x4*)g)[lane + 64 * j], scv = ((const f32x4*)(scalep + (size_t)ci * NMOD))[lane + 64 * j];
                    gp[j] = gg * (scv + 1.0f); sh[j] = ((const f32x4*)(shiftp + (size_t)ci * NMOD))[lane + 64 * j]; } }
            u32x2* o8 = (u32x2*)(hout + (size_t)row * DM) + lane;
#pragma unroll
            for (int j = 0; j < 8; ++j) { const f32x4 h = v[j] * rs * gp[j] + sh[j]; u32x2 w; w.x = cvt_pk_bf16(h.x, h.y); w.y = cvt_pk_bf16(h.z, h.w); o8[64 * j] = w; }
        }
        if (MODE == 2) { f32x4* o = (f32x4*)(fout + (size_t)row * DM) + lane;
#pragma unroll
            for (int j = 0; j < 8; ++j) o[64 * j] = v[j] * rs * gp[j]; }
    }
}

template <bool F16> struct PoolStage;
template <> struct PoolStage<true>  { typedef u32x2 T; static __device__ __forceinline__ f32x4 cvt(u32x2 r) { return h4_to_f4(r); } };
template <> struct PoolStage<false> { typedef f32x4 T; static __device__ __forceinline__ f32x4 cvt(f32x4 r) { return r; } };
__device__ __forceinline__ void rstd_phase(int G, int bx, const float* x0, const float* x1, float* rstd_out) {
    const int tid = opaque_tid(), wave = __builtin_amdgcn_readfirstlane(tid >> 6), lane = tid & 63;
    const int NWV = G * 8, gw = bx * 8 + wave, rpw = (MROWS + NWV - 1) / NWV;
    const int r0 = gw * rpw, r1 = (r0 + rpw < MROWS) ? r0 + rpw : MROWS;
    if (r0 >= r1) return;
    f32x4 a[8], b[8];
#define RSTD_LOAD(V, row) do { const float* xr_ = (row) < NCTX ? x0 + (size_t)(row) * DM : x1 + (size_t)((row) - NCTX) * DM; \
        _Pragma("unroll") for (int j = 0; j < 8; ++j) V[j] = ((const f32x4*)xr_)[lane + 64 * j]; } while (0)
#define RSTD_RED(V, row) do { float s_ = 0.f; _Pragma("unroll") for (int j = 0; j < 8; ++j) s_ += dot4(V[j]); s_ = wave_sum(s_); \
        if (lane == 0) rstd_out[row] = 1.0f / sqrtf(s_ * (1.0f / DM) + EPS); } while (0)
    RSTD_LOAD(a, r0);
    for (int row = r0; row < r1; row += 2) {
        if (row + 1 < r1) RSTD_LOAD(b, row + 1);
        RSTD_RED(a, row);
        if (row + 2 < r1) RSTD_LOAD(a, row + 2);
        if (row + 1 < r1) RSTD_RED(b, row + 1);
    }
#undef RSTD_LOAD
#undef RSTD_RED
}

template <int W>
__device__ __forceinline__ void pool_compute(const LAS f32x4* T, const LAS float* RL, int cq, int tl0, int t0, int s0, int s1, f32x4 gp, bf16_t* dcol) {
    constexpr int HW = W / 2, NR = W + 7;
    f32x4 r[NR];
    int rb = tl0 + 8 - HW; asm volatile("" : "+v"(rb));
    const LAS f32x4* Tb = T + rb * 64 + cq; const LAS float* Rb = RL + rb;
#pragma unroll
    for (int i = 0; i < NR; ++i) r[i] = Tb[i * 64] * Rb[i];
#pragma unroll
    for (int k = 0; k < 8; ++k) { const int t = t0 + tl0 + k; const int lo = (t - HW > s0) ? t - HW : s0, hi = (t - HW + W < s1) ? t - HW + W : s1;
        f32x4 sum = r[k];
#pragma unroll
        for (int i = 1; i < W; ++i) sum = sum + r[k + i];
        const f32x4 d = gp * (sum * (1.0f / (float)(hi - lo)) - r[k + HW]);
        u32x2 o; o.x = cvt_pk_bf16(d.x, d.y); o.y = cvt_pk_bf16(d.z, d.w);
        *(u32x2*)(dcol + (size_t)t * DM) = o; }
}
template <bool F16>
__device__ __forceinline__ void pool_phase(LAS unsigned char* lds, int G, int bx, const float* x0, const float* x1, const bf16_t* x16, const float* rstd, const float* ssq, const float* g, const float* scalep, bf16_t* dout) {
    LAS f32x4* T = (LAS f32x4*)lds;
    LAS float* RL = (LAS float*)(lds + 80 * 64 * 16);
    int tid = opaque_tid(), cq = tid & 63, ts = tid >> 6;
    constexpr int NU = (MROWS / 64) * 8;
    typedef typename PoolStage<F16>::T PT;
    PT preA[10], preB[F16 ? 10 : 1]; f32x4 prA, prB; unsigned pvA = 0u, pvB = 0u;
#define POOL_GEOM(u) const int tt = (u) >> 3, cb = (u) & 7, t0 = tt * 64, c0 = cb * 256 + 4 * cq; \
        int s0, s1, ci, radj; const float* xb; \
        if (t0 < NCTX) { s0 = t0 & ~(CTXSEQ - 1); s1 = s0 + CTXSEQ; xb = x0; radj = 0; ci = 8; } \
        else { s0 = NCTX + ((t0 - NCTX) & ~(LATSEQ - 1)); s1 = s0 + LATSEQ; xb = x1; radj = NCTX; ci = (t0 - NCTX) >> 12; }
#define POOL_LOAD(u, PRE, PR, PV) do { POOL_GEOM(u); (void)ci; PV = 0u; \
        _Pragma("unroll") for (int i = 0; i < 10; ++i) { const int j = ts + 8 * i, t = t0 - 8 + j; const int tc = t < s0 ? s0 : (t >= s1 ? s1 - 1 : t); \
            if constexpr (F16) PRE[i] = *(const PT*)(x16 + (size_t)tc * DM + c0); else PRE[i] = *(const PT*)(xb + (size_t)(tc - radj) * DM + c0); \
            PV |= ((j < 79 && t >= s0 && t < s1) ? 1u : 0u) << i; } \
        { const int j = tid >> 1, t = t0 - 8 + j; const int tc = t < s0 ? s0 : (t >= s1 ? s1 - 1 : t); \
          if (ssq) PR = *(const f32x4*)(ssq + (size_t)tc * 8 + (tid & 1) * 4); else { PR = (f32x4){0.f, 0.f, 0.f, 0.f}; PR.x = rstd[tc]; } \
          if (!(j < 79 && t >= s0 && t < s1)) PR = (f32x4){0.f, 0.f, 0.f, 0.f}; } } while (0)
#define POOL_UNIT(uu, PRE, PR, PV, UNEXT) do { \
        asm volatile("" : "+v"(tid)); cq = tid & 63; ts = tid >> 6; \
        _Pragma("unroll") for (int i = 0; i < 10; ++i) { const int j = ts + 8 * i; const f32x4 v = PoolStage<F16>::cvt(PRE[i]); \
            if (j < 80) T[j * 64 + cq] = ((PV >> i) & 1u) ? v : (f32x4){0.f, 0.f, 0.f, 0.f}; } \
        { float sq = (PR.x + PR.y) + (PR.z + PR.w); float rv; \
          if (ssq) { sq = add_xor1(sq); rv = 1.0f / sqrtf(sq * (1.0f / DM) + EPS); } else rv = PR.x; \
          if ((tid & 1) == 0 && (tid >> 1) < 80) RL[tid >> 1] = rv; } \
        __syncthreads(); \
        if ((UNEXT) < NU) POOL_LOAD(UNEXT, PRE, PR, PV); \
        { POOL_GEOM(uu); (void)xb; (void)radj; \
          const f32x4 gp = *(const f32x4*)(g + c0) * (*(const f32x4*)(scalep + (size_t)ci * NMOD + c0) + 1.0f); \
          const int wsel = cb >> 1; \
          if (wsel == 0) pool_compute<2>(T, RL, cq, ts * 8, t0, s0, s1, gp, dout + c0); \
          else if (wsel == 1) pool_compute<4>(T, RL, cq, ts * 8, t0, s0, s1, gp, dout + c0); \
          else if (wsel == 2) pool_compute<8>(T, RL, cq, ts * 8, t0, s0, s1, gp, dout + c0); \
          else pool_compute<16>(T, RL, cq, ts * 8, t0, s0, s1, gp, dout + c0); } \
        __syncthreads(); } while (0)
    int u = bx;
    if (u < NU) POOL_LOAD(u, preA, prA, pvA);
    if constexpr (F16) {
        if (u + G < NU) POOL_LOAD(u + G, preB, prB, pvB);
        for (; u < NU; u += 2 * G) {
            POOL_UNIT(u, preA, prA, pvA, u + 2 * G);
            if (u + G < NU) POOL_UNIT(u + G, preB, prB, pvB, u + 3 * G);
        }
    } else {
        for (; u < NU; u += G) POOL_UNIT(u, preA, prA, pvA, u + G);
        (void)preB; (void)prB; (void)pvB;
    }
#undef POOL_GEOM
#undef POOL_LOAD
#undef POOL_UNIT
}

__device__ __forceinline__ void sw_compute(LAS unsigned char* lds, int G, int bx, const bf16_t* Wt, int N, const float* shiftp  , float* out  ) {
    LAS float* ST = (LAS float*)lds;
    const int tid = opaque_tid(), wave = tid >> 6, lane = tid & 63;
    __syncthreads();
    { f32x4 sv[9];
#pragma unroll
      for (int k = 0; k < 9; ++k) sv[k] = *(const f32x4*)(shiftp + (size_t)k * NMOD + tid * 4);
#pragma unroll
      for (int k = 0; k < 9; ++k) *(LAS f32x4*)(ST + k * DM + tid * 4) = sv[k]; }
    __syncthreads();
    const int gw = bx * 8 + wave, NGW = G * 8;
    u32x2 wv[8], wn[8], wm[8];
    int n = gw;
    if (n < N) {
#pragma unroll
        for (int j = 0; j < 8; ++j) wn[j] = *(const u32x2*)(Wt + (size_t)n * DM + j * 256 + lane * 4); }
    if (n + NGW < N) {
#pragma unroll
        for (int j = 0; j < 8; ++j) wm[j] = *(const u32x2*)(Wt + (size_t)(n + NGW) * DM + j * 256 + lane * 4); }
    for (; n < N; n += NGW) {
#pragma unroll
        for (int j = 0; j < 8; ++j) { wv[j] = wn[j]; wn[j] = wm[j]; }
        if (n + 2 * NGW < N) {
#pragma unroll
            for (int j = 0; j < 8; ++j) wm[j] = *(const u32x2*)(Wt + (size_t)(n + 2 * NGW) * DM + j * 256 + lane * 4); }
        f32x4 wf[8];
#pragma unroll
        for (int j = 0; j < 8; ++j) wf[j] = (f32x4){__uint_as_float(wv[j].x << 16), __uint_as_float(wv[j].x & 0xffff0000u), __uint_as_float(wv[j].y << 16), __uint_as_float(wv[j].y & 0xffff0000u)};
#pragma unroll 1
        for (int ci = 0; ci < 9; ++ci) { f32x4 a = (f32x4){0.f, 0.f, 0.f, 0.f};
#pragma unroll
            for (int j = 0; j < 8; ++j) a = a + *(const LAS f32x4*)(ST + ci * DM + j * 256 + lane * 4) * wf[j];
            const float r = wave_sum((a.x + a.y) + (a.z + a.w));
            if (lane == 0) out[(size_t)ci * N + n] = r; }
    }
}

__device__ __forceinline__ void sgu_phase(LAS unsigned char* lds, int G, int bx, const bf16_t* Z, const float* vss, const float* ng, const bf16_t* Wbf, const float* bs, bf16_t* Sout) {
    const int tid = opaque_tid(), wave = tid >> 6, lane = tid & 63, r32 = lane & 31, hi = lane >> 5;
    LAS float* RS = (LAS float*)(lds + 131072);
    LAS float* EB = (LAS float*)(lds + 65536 + wave * 8192);
    const int sr = tid >> 4, sc = (tid & 15) * 8;
    const int pb = wave & 3, ct = wave >> 2;
    const int eg = lane & 7, rsub = lane >> 3;
    constexpr int NU = (MROWS / 128) * 8;
    bf16x8 raw[8]; f32x4 part[2];
#define SGU_PREFETCH(u) do { const int chunk_ = (u) >> 3, g_ = (u) & 7, row0_ = chunk_ * 128; \
        _Pragma("unroll") for (int kt = 0; kt < 2; ++kt) _Pragma("unroll") for (int c2 = 0; c2 < 2; ++c2) _Pragma("unroll") for (int hf = 0; hf < 2; ++hf) \
            raw[(kt * 2 + c2) * 2 + hf] = *(const bf16x8*)(Z + (size_t)(row0_ + kt * 64 + hf * 32 + sr) * 4096 + 2048 + g_ * 256 + c2 * 128 + sc); \
        { const f32x4* p_ = (const f32x4*)(vss + (size_t)(row0_ + (tid >> 2)) * 32 + (tid & 3) * 8); part[0] = p_[0]; part[1] = p_[1]; } } while (0)
    int u = bx;
    if (u < NU) SGU_PREFETCH(u);
    for (; u < NU; u += G) {
        const int chunk = u >> 3, g = u & 7, row0 = chunk * 128;
        { const f32x4 a = part[0] + part[1]; float sq = (a.x + a.y) + (a.z + a.w); sq = add_xor1(sq); sq = add_xor2(sq);
          if ((tid & 3) == 0) RS[tid >> 2] = 1.0f / sqrtf(sq * (1.0f / DM) + EPS); }
        __syncthreads();
#pragma unroll
        for (int kt = 0; kt < 2; ++kt)
#pragma unroll
            for (int c2 = 0; c2 < 2; ++c2)
#pragma unroll
                for (int hf = 0; hf < 2; ++hf) { const int q = kt * 64 + hf * 32 + sr, col = c2 * 128 + sc; const bf16x8 rw = raw[(kt * 2 + c2) * 2 + hf];
                    const float rs = RS[q]; const f32x4 n0 = *(const f32x4*)(ng + g * 256 + col) * rs, n1 = *(const f32x4*)(ng + g * 256 + col + 4) * rs;
                    u32x4 w; w.x = cvt_pk_bf16(bf2f((bf16_t)rw[0]) * n0.x, bf2f((bf16_t)rw[1]) * n0.y); w.y = cvt_pk_bf16(bf2f((bf16_t)rw[2]) * n0.z, bf2f((bf16_t)rw[3]) * n0.w);
                    w.z = cvt_pk_bf16(bf2f((bf16_t)rw[4]) * n1.x, bf2f((bf16_t)rw[5]) * n1.y); w.w = cvt_pk_bf16(bf2f((bf16_t)rw[6]) * n1.z, bf2f((bf16_t)rw[7]) * n1.w);
                    *(LAS u32x4*)(lds + (kt * 2 + c2) * 16384 + att::v_st(hf * 32 + sr, sc)) = w; }
        __syncthreads();
        bf16x8 ucur[8];
#pragma unroll
        for (int hh = 0; hh < 2; ++hh)
#pragma unroll
            for (int i = 0; i < 4; ++i) ucur[hh * 4 + i] = *(const bf16x8*)(Z + (size_t)(row0 + pb * 32 + rsub + 8 * i) * 4096 + g * 256 + ct * 128 + hh * 64 + eg * 8);
        bf16x8 pa[8];
#pragma unroll
        for (int kk = 0; kk < 8; ++kk) pa[kk] = *(const bf16x8*)(Wbf + ((size_t)(g * 128 + pb * 32 + r32)) * 128 + kk * 16 + hi * 8);
        f32x16 o[4];
#pragma unroll
        for (int d = 0; d < 4; ++d) o[d] = f32x16{};
        const int vb = (int)(unsigned)(uintptr_t)lds + ct * 16384 + att::v_rd_base(lane);
        att::pv_d0(o, vb, pa[0], pa[1], pa[2], pa[3]);
        att::pv_d0(o, vb + 2 * 16384, pa[4], pa[5], pa[6], pa[7]);
        if (u + G < NU) SGU_PREFETCH(u + G);
        float bias[16];
#pragma unroll
        for (int r = 0; r < 16; ++r) bias[r] = bs[g * 128 + pb * 32 + att::crow(r, hi)];
#pragma unroll
        for (int hh = 0; hh < 2; ++hh) {
#pragma unroll
            for (int dl = 0; dl < 2; ++dl)
#pragma unroll
                for (int r = 0; r < 16; ++r) { const int rw = att::crow(r, hi), cl = dl * 32 + r32; EB[rw * 64 + (cl ^ ((rw & 7) << 3))] = o[hh * 2 + dl][r] + bias[r]; }
            asm volatile("s_waitcnt lgkmcnt(0)" ::: "memory");
#pragma unroll
            for (int i = 0; i < 4; ++i) { const int rw = rsub + 8 * i; const LAS f32x4* ep = (const LAS f32x4*)(EB + rw * 64 + ((eg ^ (rw & 7)) << 3));
                const f32x4 v0 = ep[0], v1 = ep[1]; const bf16x8 uq = ucur[hh * 4 + i];
                u32x4 w; w.x = cvt_pk_bf16(bf2f((bf16_t)uq[0]) * v0.x, bf2f((bf16_t)uq[1]) * v0.y); w.y = cvt_pk_bf16(bf2f((bf16_t)uq[2]) * v0.z, bf2f((bf16_t)uq[3]) * v0.w);
                w.z = cvt_pk_bf16(bf2f((bf16_t)uq[4]) * v1.x, bf2f((bf16_t)uq[5]) * v1.y); w.w = cvt_pk_bf16(bf2f((bf16_t)uq[6]) * v1.z, bf2f((bf16_t)uq[7]) * v1.w);
                *(u32x4*)(Sout + (size_t)(row0 + pb * 32 + rw) * DM + g * 256 + ct * 128 + hh * 64 + eg * 8) = w; }
            asm volatile("s_waitcnt lgkmcnt(0)" ::: "memory");
        }
        __syncthreads();
    }
#undef SGU_PREFETCH
}

__device__ __forceinline__ float lam_of(const float* lamp, int lane) {
    const float a = lamp[lane] * lamp[128 + lane] + lamp[64 + lane] * lamp[192 + lane], b = lamp[256 + lane] * lamp[384 + lane] + lamp[320 + lane] * lamp[448 + lane];
    return expf(wave_sum(a)) - expf(wave_sum(b)) + LAM_INIT;
}
__device__ __forceinline__ void attn_phase(LAS unsigned char* lds, int G, int vcu, const bf16_t* Qb, bf16_t* Oout, const bf16_t* Kc, const bf16_t* Vc, const bf16_t* Kall, const bf16_t* Vall,
                                           float* scratch, const float* lamp, const float* subg) {
    const int NU = 256 + 1024;
    for (int u = vcu; u < NU; u += G) {
        size_t rowbase; const bf16_t *Kb, *Vb; int seq, h;
        if (u < 256) { const int b = u >> 3; h = u & 7; rowbase = (size_t)b * CTXSEQ; Kb = Kc + rowbase * DM; Vb = Vc + rowbase * DM; seq = CTXSEQ; }
        else { const int v = u - 256, bh = v >> 4, qb = v & 15, b = bh >> 3; h = bh & 7; rowbase = (size_t)NCTX + (size_t)b * LATSEQ + (size_t)qb * 256;
            Kb = Kall + (size_t)b * KVLEN * DM; Vb = Vall + (size_t)b * KVLEN * DM; seq = KVLEN; }
        f32x16 o[8];
        att::attn_pass2(Qb + rowbase * DM + h * 256, Kb + h * 256, Vb + h * 256, seq, lds, o);
        { int tid = opaque_tid(); f32x4* Sv = (f32x4*)(scratch + ((size_t)vcu * 512 + tid) * 128);
#pragma unroll
          for (int d = 0; d < 8; ++d)
#pragma unroll
              for (int q = 0; q < 4; ++q) Sv[d * 4 + q] = (f32x4){o[d][4 * q], o[d][4 * q + 1], o[d][4 * q + 2], o[d][4 * q + 3]}; }
        att::attn_pass2(Qb + rowbase * DM + h * 256 + 128, Kb + h * 256 + 128, Vb + h * 256, seq, lds, o);
        const int tid = opaque_tid(), wid = tid >> 6, lane = tid & 63, r32 = lane & 31, hi = lane >> 5;
        const f32x4* S = (const f32x4*)(scratch + ((size_t)vcu * 512 + tid) * 128);
        const float lam = lam_of(lamp, lane);
        float ss[16];
#pragma unroll
        for (int r = 0; r < 16; ++r) ss[r] = 0.f;
#pragma unroll
        for (int d = 0; d < 8; ++d)
#pragma unroll
            for (int q = 0; q < 4; ++q) { const f32x4 t = S[d * 4 + q];
#pragma unroll
                for (int i = 0; i < 4; ++i) { const float v = t[i] - lam * o[d][4 * q + i]; o[d][4 * q + i] = v; ss[4 * q + i] += v * v; } }
        bf16_t* Ob = Oout + (rowbase + wid * 32) * DM + h * 256 + r32;
        float gg[8];
#pragma unroll
        for (int d = 0; d < 8; ++d) gg[d] = subg[d * 32 + r32] * (1.0f - LAM_INIT);
#pragma unroll
        for (int r = 0; r < 16; ++r) { float sq = ss[r];
#pragma unroll
            for (int of = 1; of < 32; of <<= 1) sq += __shfl_xor(sq, of);
            const float rs = 1.0f / sqrtf(sq * (1.0f / 256.0f) + EPS);
            bf16_t* op = Ob + (size_t)att::crow(r, hi) * DM;
#pragma unroll
            for (int d = 0; d < 8; ++d) op[d * 32] = f2bf(o[d][r] * rs * gg[d]); }
    }
}

__device__ __forceinline__ void transpose_item(const float* W, int K, int N, bf16_t* WT, int k0, int n0, int drow0, LAS float* scr, int lane) {
#pragma unroll 8
    for (int i = 0; i < 32; ++i) { const int kk = 2 * i + (lane >> 5); scr[kk * 33 + (lane & 31)] = W[(size_t)(k0 + kk) * N + n0 + (lane & 31)]; }
    asm volatile("s_waitcnt lgkmcnt(0)" ::: "memory");
    const int c = lane & 7;
#pragma unroll
    for (int j = 0; j < 4; ++j) { const int n = (lane >> 3) + 8 * j; const LAS float* s = scr + (8 * c) * 33 + n;
        u32x4 o; o.x = cvt_pk_bf16(s[0 * 33], s[1 * 33]); o.y = cvt_pk_bf16(s[2 * 33], s[3 * 33]); o.z = cvt_pk_bf16(s[4 * 33], s[5 * 33]); o.w = cvt_pk_bf16(s[6 * 33], s[7 * 33]);
        *(u32x4*)(WT + (size_t)(drow0 + n) * K + k0 + 8 * c) = o; }
    asm volatile("s_waitcnt lgkmcnt(0)" ::: "memory");
}
__device__ __forceinline__ int qkv_drow(int n0) {
    if (n0 >= 4096) return n0;
    const int sec = n0 >> 11, wi = n0 & 2047, h = wi >> 8, rem = wi & 255, mp = rem >> 7, axis = (rem >> 6) & 1, half = (rem >> 5) & 1;
    return sec * 2048 + h * 256 + half * 128 + (mp * 2 + axis) * 32;
}
__device__ __forceinline__ int ffnin_drow(int n0) { const int bj = n0 >= FFH ? 1 : 0, jj = n0 - bj * FFH; return (jj >> 7) * 256 + bj * 128 + (jj & 127); }

struct Args { const float* in[24]; float* out; unsigned char* ws; int ph_lo, ph_hi, li, pad; };

struct DArgs { GAS const float* in[24]; GAS float* out; GAS unsigned char* ws; int ph_lo, ph_hi, li, pad; };
static_assert(sizeof(DArgs) == sizeof(Args), "argument block layout");
typedef const DArgs __attribute__((address_space(4))) CArgs;
__device__ __forceinline__ void prologue(LAS unsigned char* lds, CArgs* ap, int G, int bx) {
    CArgs& a = *ap;
#define AIN(k) ((const float*)a.in[k])
    const int tid = opaque_tid(), wave = tid >> 6, lane = tid & 63;
    unsigned char* ws = (unsigned char*)a.ws;
    {
        LAS float* ST = (LAS float*)lds;
        LAS float* RED = (LAS float*)(lds + 73728);
        const float* cvec = AIN(4); const float* cctx = AIN(5); const float* ada_w = AIN(6); const float* ada_b = AIN(7);
        float* MOD = (float*)(ws + WS_MOD);
        for (int i = tid; i < 9 * DM; i += 512) { const int ci = i >> 11, k = i & 2047; const float c = ci < 8 ? cvec[ci * DM + k] : cctx[k]; ST[i] = c / (1.0f + expf(-c)); }
        __syncthreads();
        const int cq = lane & 15, ks = lane >> 4;
        for (int au = bx; au < 768; au += G) {
            const int l = au / 192, col0 = (au % 192) * 64;
            const float* wp = ada_w + ((size_t)l * DM + wave * 256 + ks) * NMOD + col0 + 4 * cq;
            f32x4 acc[9];
#pragma unroll
            for (int ci = 0; ci < 9; ++ci) acc[ci] = (f32x4){0.f, 0.f, 0.f, 0.f};
#pragma unroll 4
            for (int it = 0; it < 64; ++it) { const f32x4 wv = *(const f32x4*)(wp + (size_t)it * 4 * NMOD); const int k = wave * 256 + it * 4 + ks;
#pragma unroll
                for (int ci = 0; ci < 9; ++ci) acc[ci] = acc[ci] + wv * ST[ci * DM + k]; }
#pragma unroll
            for (int ci = 0; ci < 9; ++ci)
#pragma unroll
                for (int i = 0; i < 4; ++i) { float v = acc[ci][i]; v += __shfl_xor(v, 16); v += __shfl_xor(v, 32); acc[ci][i] = v; }
            if (lane < 16) {
#pragma unroll
                for (int ci = 0; ci < 9; ++ci) *(LAS f32x4*)(RED + (wave * 16 + cq) * 36 + ci * 4) = acc[ci]; }
            __syncthreads();
            for (int t = tid; t < 576; t += 512) { const int ci = t >> 6, col = t & 63; float s = ada_b[l * NMOD + col0 + col];
#pragma unroll
                for (int w = 0; w < 8; ++w) s += RED[(w * 16 + (col >> 2)) * 36 + ci * 4 + (col & 3)];
                MOD[(size_t)(l * 9 + ci) * NMOD + col0 + col] = s; }
            __syncthreads();
        }
    }
    __syncthreads();
    {
        LAS float* scr = (LAS float*)(lds + wave * 16384);
        const int gw = bx * 8 + wave, NGW = G * 8;
        constexpr int I_POOL = 8 * 128, I_SIN = 32 * 128, I_SOUT = 32 * 64, I_QKV = 32 * 192, I_WO = 32 * 64, I_FIN = 4 * 32 * 352, I_FOUT = 4 * 88 * 64;
        constexpr int NITEMS = I_POOL + I_SIN + I_SOUT + I_QKV + I_WO + I_FIN + I_FOUT;
        for (int it = gw; it < NITEMS; it += NGW) {
            int r = it;
            if (r < I_POOL) { const int mat = r >> 7, q = r & 127, kb = q >> 4, nb = q & 15;
                transpose_item(AIN(10) + (size_t)mat * 512 * 512, 512, 512, (bf16_t*)(ws + WS_POOLW) + (size_t)mat * 512 * 512, kb * 64, nb * 32, nb * 32, scr, lane); continue; } r -= I_POOL;
            if (r < I_SIN) { const int kb = r >> 7, nb = r & 127; transpose_item(AIN(12), DM, 4096, (bf16_t*)(ws + WS_SGUIN), kb * 64, nb * 32, nb * 32, scr, lane); continue; } r -= I_SIN;
            if (r < I_SOUT) { const int kb = r >> 6, nb = r & 63; transpose_item(AIN(16), DM, DM, (bf16_t*)(ws + WS_SGUOUT), kb * 64, nb * 32, nb * 32, scr, lane); continue; } r -= I_SOUT;
            if (r < I_QKV) { const int kb = r / 192, nb = r % 192; transpose_item(AIN(17), DM, 6144, (bf16_t*)(ws + WS_WQKV), kb * 64, nb * 32, qkv_drow(nb * 32), scr, lane); continue; } r -= I_QKV;
            if (r < I_WO) { const int kb = r >> 6, nb = r & 63; transpose_item(AIN(20), DM, DM, (bf16_t*)(ws + WS_WO), kb * 64, nb * 32, nb * 32, scr, lane); continue; } r -= I_WO;
            if (r < I_FIN) { const int l = r / (32 * 352), q = r % (32 * 352), kb = q / 352, nb = q % 352;
                transpose_item(AIN(21) + (size_t)l * DM * 2 * FFH, DM, 2 * FFH, (bf16_t*)(ws + WS_FFNIN + (size_t)l * FFNIN_L), kb * 64, nb * 32, ffnin_drow(nb * 32), scr, lane); continue; } r -= I_FIN;
            { const int l = r / (88 * 64), q = r % (88 * 64), kb = q >> 6, nb = q & 63;
                transpose_item(AIN(22) + (size_t)l * FFH * DM, FFH, DM, (bf16_t*)(ws + WS_FFNOUT + (size_t)l * FFNOUT_L), kb * 64, nb * 32, nb * 32, scr, lane); }
        }
    }
    {
        const size_t gt = (size_t)bx * 512 + tid, NT = (size_t)G * 512;
        for (size_t i = gt; i < 8 * 128 * 128 / 8; i += NT) { const float* src = AIN(14) + i * 8; const f32x4 v0 = *(const f32x4*)src, v1 = *(const f32x4*)(src + 4);
            u32x4 w; w.x = cvt_pk_bf16(v0.x, v0.y); w.y = cvt_pk_bf16(v0.z, v0.w); w.z = cvt_pk_bf16(v1.x, v1.y); w.w = cvt_pk_bf16(v1.z, v1.w); *(u32x4*)((bf16_t*)(ws + WS_SGUWS) + i * 8) = w; }
        for (size_t i = gt; i < 64 * 32; i += NT) { const int pos = (int)(i >> 5), f = (int)(i & 31);
            const float inv = powf(10000.0f, -(float)f / 32.0f); const float angf = (float)pos * inv; const double ang = (double)angf;
            const double kq = rint(ang * 0.6366197723675814); double r = fma(-kq, 1.5707963267948966, ang); r = fma(-kq, 6.123233995736766e-17, r);
            const int q = ((int)kq) & 3; const double r2 = r * r;
            const double sn = r * (1.0 + r2 * (-1.0 / 6 + r2 * (1.0 / 120 + r2 * (-1.0 / 5040 + r2 * (1.0 / 362880 + r2 * (-1.0 / 39916800 + r2 * (1.0 / 6227020800.0)))))));
            const double cs = 1.0 + r2 * (-0.5 + r2 * (1.0 / 24 + r2 * (-1.0 / 720 + r2 * (1.0 / 40320 + r2 * (-1.0 / 3628800 + r2 * (1.0 / 479001600.0 + r2 * (-1.0 / 87178291200.0)))))));
            const double sv = (q == 0) ? sn : (q == 1) ? cs : (q == 2) ? -sn : -cs, cv = (q == 0) ? cs : (q == 1) ? -sn : (q == 2) ? -cs : sn;
            float* rp = (float*)(ws + WS_ROPE) + i * 2; rp[0] = (float)cv; rp[1] = (float)sv; }
    }
    rstd_phase(G, bx, AIN(0), AIN(1), (float*)(ws + WS_RSTD));
#undef AIN
}

__device__ __forceinline__ void cache_convert(CArgs* ap, int G, int bx) {
    CArgs& a = *ap;
    unsigned char* ws = (unsigned char*)a.ws;
    const int tid = opaque_tid();
    const size_t gt = (size_t)bx * 512 + tid, NT = (size_t)G * 512;
    const size_t NC8 = (size_t)8 * PAST * DM / 8;
    for (size_t i = gt; i < 2 * NC8; i += NT) { const bool isv = i >= NC8; const size_t j = isv ? i - NC8 : i; const size_t e = j * 8, b = e / ((size_t)PAST * DM), rem = e % ((size_t)PAST * DM);
        const float* src = (const float*)(isv ? a.in[3] : a.in[2]) + e; bf16_t* dst = (bf16_t*)(ws + (isv ? WS_VALL : WS_KALL)) + b * (size_t)KVLEN * DM + rem;
        const f32x4 v0 = *(const f32x4*)src, v1 = *(const f32x4*)(src + 4);
        u32x4 w; w.x = cvt_pk_bf16(v0.x, v0.y); w.y = cvt_pk_bf16(v0.z, v0.w); w.z = cvt_pk_bf16(v1.x, v1.y); w.w = cvt_pk_bf16(v1.z, v1.w); *(u32x4*)dst = w; }
}

__device__ __forceinline__ CArgs* kargs() { CArgs* p = (CArgs*)__builtin_amdgcn_kernarg_segment_ptr(); asm volatile("" : "+s"(p)); return p; }
#define KA (kargs())
__global__ void __launch_bounds__(512, 2) mk_fwd(Args a_unused) {
    extern __shared__ __attribute__((aligned(16))) unsigned char lds_raw[];
    LAS unsigned char* lds = (LAS unsigned char*)lds_raw;
    volatile LAS unsigned* MISC = (volatile LAS unsigned*)(lds + MISC_OFF);
    const int tid = threadIdx.x, lane = tid & 63, wave = __builtin_amdgcn_readfirstlane(tid >> 6);
    const int G0 = gridDim.x, bx0 = blockIdx.x;
    const int vcu0 = (G0 % 8 == 0) ? (bx0 % 8) * (G0 / 8) + bx0 / 8 : bx0;
    GAS unsigned char* ws0 = KA->ws;
    unsigned* ctl = (unsigned*)((unsigned char*)ws0 + WS_CTL);
    for (int u = tid; u < (LDS_BYTES - LDSCTL_OFF) / 4; u += 512) ((LAS unsigned*)(lds + LDSCTL_OFF))[u] = 0u;
    __syncthreads();
    XcdBarrier bar = xcd_barrier_post(ctl + CW_BAR + KA->li * XCD_BAR_WORDS, MISC + 8);
#if MK_ONE_LAUNCH
    constexpr int lo = 0, hi = NPH;
#else
    const int lo = KA->ph_lo, hi = KA->ph_hi;
#endif
#ifndef MK_MASK
#define MK_MASK 0xffff
#endif
#define EN(b) ((MK_MASK >> (b)) & 1)
#define IN(k) (lo <= (k) && (k) < hi)
#define SEAM(k) do { if ((k) + 1 < hi) { XcdBarrier b2_ = bar; asm volatile("" : "+s"(b2_.bar), "+s"(b2_.x)); xcd_barrier(b2_); } } while (0)

#define PHASE_BEGIN \
    int G = G0, bx = bx0, vcu = vcu0; GAS unsigned char* wsg = ws0; asm volatile("" : "+s"(G), "+s"(bx), "+s"(vcu), "+s"(wsg)); unsigned char* ws = (unsigned char*)wsg; \
    bf16_t* X = (bf16_t*)(ws + WS_X); float* MOD = (float*)(ws + WS_MOD); float* RSTD = (float*)(ws + WS_RSTD); \
    float* SSQ = (float*)(ws + WS_SSQ); float* SW = (float*)(ws + WS_SW); \
    bf16_t* Hb = (bf16_t*)(ws + WS_H); bf16_t* HID = (bf16_t*)(ws + WS_HID); \
    bf16_t* R3 = (bf16_t*)((float*)KA->out); \
    (void)vcu; (void)RSTD; (void)SSQ; (void)SW; (void)Hb; (void)HID; (void)R3; (void)MOD; (void)X;
#define LAYER_VARS \
    const int kind = (l == 3) ? 0 : l; const float* modl = MOD + (size_t)l * 9 * NMOD; \
    const float* xs0 = (const float*)KA->in[0]; const float* xs1 = (const float*)KA->in[1]; const bf16_t* xs16 = (l == 0) ? (const bf16_t*)nullptr : (const bf16_t*)X; \
    const float* gmix = ((const float*)KA->in[8]) + l * DM; const float* gffn = ((const float*)KA->in[9]) + l * DM; \
    (void)kind; (void)modl; (void)xs0; (void)xs1; (void)xs16; (void)gmix; (void)gffn;

    if (EN(0) && IN(0)) { PHASE_BEGIN prologue(lds, KA, G, bx); SEAM(0); }

    for (int l = 0; l < 4; ++l) {
        const int pb = 1 + 5 * l;
        if (IN(pb + 0)) { PHASE_BEGIN LAYER_VARS
            if (kind == 0) { if (EN(2)) {
                if (l == 0) {
#pragma unroll 1
                    for (int sidx = 0; sidx < 6; ++sidx) {
                        const bf16_t* Wt = (sidx < 4) ? (const bf16_t*)(ws + WS_FFNIN + (size_t)sidx * FFNIN_L) : (sidx == 4) ? (const bf16_t*)(ws + WS_SGUIN) : (const bf16_t*)(ws + WS_WQKV);
                        const int N = (sidx < 4) ? 2 * FFH : (sidx == 4) ? 4096 : 6144;
                        const float* shp = (sidx < 4) ? MOD + (size_t)sidx * 9 * NMOD + 3 * DM : MOD + (size_t)(sidx - 3) * 9 * NMOD;
                        float* outp = SW + ((sidx < 4) ? sidx * SW_G1_L : (sidx == 4) ? SW_SGU : SW_QKV);
                        sw_compute(lds, G, bx, Wt, N, shp, outp);
                    }
                    __syncthreads();
                }
                if (l == 0) pool_phase<false>(lds, G, bx, xs0, xs1, xs16, RSTD, (const float*)nullptr, gmix, modl + 1 * DM, HID);
                else pool_phase<true>(lds, G, bx, xs0, xs1, xs16, RSTD, (const float*)SSQ, gmix, modl + 1 * DM, HID); } }
            else if (kind == 1) { if (EN(3)) { const pg8::Gemm g = pg8::mk_gemm(Hb, (const bf16_t*)(ws + WS_SGUIN), DM, DM); pg8::StaticOrder S; S.init(MROWS, 4096, G, bx);
                pg8::EpiGelu E{HID, (float*)(ws + WS_VSS), SSQ, SW + SW_SGU}; pg8::gemm_phase(lds, g, S, E); } }
            else if (EN(4)) { cache_convert(KA, G, bx);
                const pg8::Gemm g = pg8::mk_gemm(Hb, (const bf16_t*)(ws + WS_WQKV), DM, DM); pg8::StaticOrder S; S.init(MROWS, 6144, G, bx);
                pg8::EpiQKV E{(bf16_t*)(ws + WS_Q), (bf16_t*)(ws + WS_KALL), (bf16_t*)(ws + WS_VALL), (bf16_t*)(ws + WS_KC), (bf16_t*)(ws + WS_VC),
                              ((float*)KA->out) + (size_t)MROWS * DM, ((float*)KA->out) + (size_t)MROWS * DM + (size_t)NCTX * DM, (const float*)(ws + WS_ROPE), SSQ, SW + SW_QKV};
                pg8::gemm_phase(lds, g, S, E); }
            SEAM(pb + 0);
        }
        if (IN(pb + 1)) { PHASE_BEGIN LAYER_VARS
            if (kind == 0) { if (EN(5)) { const int slot = l / 3; const pg8::Gemm g = pg8::mk_gemm(HID, (const bf16_t*)(ws + WS_POOLW) + (size_t)slot * DM * 512, DM, 512, 512); pg8::StaticOrder S; S.init(MROWS, DM, G, bx);
                pg8::EpiRes E{xs0, xs1, xs16, X, modl + 2 * DM, ((const float*)KA->in[11]) + slot * DM, SSQ, Hb, gffn, modl + 4 * DM}; pg8::gemm_phase(lds, g, S, E); } }
            else if (kind == 1) { if (EN(6)) sgu_phase(lds, G, bx, HID, (const float*)(ws + WS_VSS), ((const float*)KA->in[13]), (const bf16_t*)(ws + WS_SGUWS), ((const float*)KA->in[15]), R3); }
            else if (EN(7)) attn_phase(lds, G, vcu, (const bf16_t*)(ws + WS_Q), R3, (const bf16_t*)(ws + WS_KC), (const bf16_t*)(ws + WS_VC), (const bf16_t*)(ws + WS_KALL), (const bf16_t*)(ws + WS_VALL),
                            (float*)(ws + WS_ATTS), ((const float*)KA->in[18]), ((const float*)KA->in[19]));
            SEAM(pb + 1);
        }
        if (EN(8) && IN(pb + 2) && phase_nonempty(pb + 2)) { PHASE_BEGIN LAYER_VARS
            { const pg8::Gemm g = pg8::mk_gemm(R3, (const bf16_t*)(ws + (kind == 1 ? WS_SGUOUT : WS_WO)), DM, DM); pg8::StaticOrder S; S.init(MROWS, DM, G, bx);
                pg8::EpiRes E{nullptr, nullptr, X, X, modl + 2 * DM, nullptr, SSQ, Hb, gffn, modl + 4 * DM}; pg8::gemm_phase(lds, g, S, E); }
            SEAM(pb + 2);
        }
        if (EN(10) && IN(pb + 3)) { PHASE_BEGIN LAYER_VARS const pg8::Gemm g = pg8::mk_gemm(Hb, (const bf16_t*)(ws + WS_FFNIN + (size_t)l * FFNIN_L), DM, DM); pg8::StaticOrder S; S.init(MROWS, 2 * FFH, G, bx);
            pg8::EpiSwiglu E{HID, SSQ, SW + l * SW_G1_L}; pg8::gemm_phase(lds, g, S, E); SEAM(pb + 3); }
        if (EN(11) && IN(pb + 4)) { PHASE_BEGIN LAYER_VARS const pg8::Gemm g{HID, (const bf16_t*)(ws + WS_FFNOUT + (size_t)l * FFNOUT_L), 64, FFH, 0, 256u * 64u * 2u, (size_t)(FFH / 64) * 256 * 64 * 2}; pg8::StaticOrder S; S.init(MROWS, DM, G, bx, 4);
            const bool nxg = (l == 0 || l == 1);
            pg8::EpiRes E{nullptr, nullptr, X, X, modl + 5 * DM, nullptr, (l == 3) ? (float*)nullptr : SSQ, nxg ? Hb : (bf16_t*)nullptr, ((const float*)KA->in[8]) + (l + 1) * DM, MOD + (size_t)(l + 1) * 9 * NMOD + 1 * DM};
            if (l == 3) { pg8::EpiDelta ED{Hb, modl + 5 * DM, nullptr}; pg8::gemm_phase(lds, g, S, ED); }
            else pg8::gemm_phase(lds, g, S, E);
            SEAM(pb + 4); }
    }
    if (EN(12) && IN(21)) { PHASE_BEGIN rowop_phase<2>(G, bx, (const float*)X, nullptr, ((const float*)KA->in[23]), nullptr, nullptr, nullptr, Hb, ((float*)KA->out)); }
#undef PHASE_BEGIN
#undef LAYER_VARS
#undef IN
#undef SEAM
}

extern "C" void kernel_launch(void* const* d_in, const int* in_sizes, int n_in, void* d_out, int out_size, void* d_ws, size_t ws_size, hipStream_t stream) {
    static int grid = 0;
    if (grid == 0) {
        if (n_in != 24 || in_sizes[0] != NCTX * DM || in_sizes[1] != NLAT * DM || ws_size < WS_END) {
            fprintf(stderr, "kernel_launch: unexpected shapes: n_in %d in0 %d in1 %d out %d ws %zu (need %zu)\n", n_in, n_in > 0 ? in_sizes[0] : -1, n_in > 1 ? in_sizes[1] : -1, out_size, ws_size, (size_t)WS_END); grid = -1; return; }
        int dev = 0, cus = 0;
        if (hipGetDevice(&dev) != hipSuccess || hipDeviceGetAttribute(&cus, hipDeviceAttributeMultiprocessorCount, dev) != hipSuccess) { grid = -1; return; }
        if (hipFuncSetAttribute((const void*)mk_fwd, hipFuncAttributeMaxDynamicSharedMemorySize, LDS_BYTES) != hipSuccess) { fprintf(stderr, "kernel_launch: hipFuncSetAttribute failed\n"); grid = -1; return; }
        int per_cu = 0;
        if (hipOccupancyMaxActiveBlocksPerMultiprocessor(&per_cu, (const void*)mk_fwd, 512, LDS_BYTES) != hipSuccess || per_cu < 1) { fprintf(stderr, "kernel_launch: occupancy query says %d\n", per_cu); }
        (void)hipGetLastError();
        grid = cus > 0 ? cus : 256;
    }
    if (grid < 0) return;
    (void)hipMemsetAsync((char*)d_ws + WS_CTL, 0, CTL_ZERO_BYTES, stream);
    Args a{};
    for (int i = 0; i < 24; ++i) a.in[i] = (const float*)d_in[i];
    a.out = (float*)d_out; a.ws = (unsigned char*)d_ws; a.pad = 0;
#if MK_ONE_LAUNCH
    a.ph_lo = 0; a.ph_hi = NPH; a.li = 0;
    hipLaunchKernelGGL(mk_fwd, dim3(grid), dim3(512), LDS_BYTES, stream, a);
#else
    int li = 0;
    for (int p = 0; p < NPH; ++p) { if (!phase_nonempty(p)) continue; a.ph_lo = p; a.ph_hi = p + 1; a.li = li++;
        hipLaunchKernelGGL(mk_fwd, dim3(grid), dim3(512), LDS_BYTES, stream, a); }
#endif
    const hipError_t le = hipPeekAtLastError();
    if (le != hipSuccess) fprintf(stderr, "kernel_launch: launch failed: %s\n", hipGetErrorName(le));
}
```

```cpp
#include <hip/hip_runtime.h>
#include <hip/hip_bf16.h>
#include <cstdio>
#include <cstdint>

#ifndef MK_ONE_LAUNCH
#define MK_ONE_LAUNCH 1
#endif

#define GAS __attribute__((address_space(1)))
#define LAS __attribute__((address_space(3)))
typedef unsigned short bf16_t;
typedef short bf16x8 __attribute__((ext_vector_type(8)));
typedef short s16x4 __attribute__((ext_vector_type(4)));
typedef float f32x4 __attribute__((ext_vector_type(4)));
typedef float f32x2 __attribute__((ext_vector_type(2)));
typedef float f32x16 __attribute__((ext_vector_type(16)));
typedef unsigned u32x4 __attribute__((ext_vector_type(4)));
typedef unsigned u32x2 __attribute__((ext_vector_type(2)));

constexpr int DM = 2048, NCTX = 8192, NLAT = 32768, MROWS = NCTX + NLAT, FFH = 5632, NMOD = 6 * DM;
constexpr int LATSEQ = 4096, CTXSEQ = 256, PAST = 256, KVLEN = PAST + LATSEQ;
constexpr float EPS = 1e-6f;
constexpr float LAM_INIT = 0.47071301834358416f;

constexpr size_t MiB = 1u << 20;
constexpr size_t WS_CTL = 0, CTL_ZERO_BYTES = 1 * MiB;
constexpr size_t WS_MOD = 1 * MiB;
constexpr size_t WS_ROPE = 3 * MiB;
constexpr size_t WS_RSTD = 4 * MiB;
constexpr size_t WS_VSS = 5 * MiB;
constexpr size_t WS_SGUWS = 10 * MiB;
constexpr size_t WS_POOLW = 11 * MiB;
constexpr size_t WS_SGUIN = 15 * MiB;
constexpr size_t WS_SGUOUT = 31 * MiB;
constexpr size_t WS_WQKV = 39 * MiB;
constexpr size_t WS_WO = 63 * MiB;
constexpr size_t WS_FFNIN = 71 * MiB;
constexpr size_t WS_FFNOUT = 247 * MiB;
constexpr size_t WS_X = 336 * MiB;
constexpr size_t WS_H = 656 * MiB;
constexpr size_t WS_HID = 816 * MiB;
constexpr size_t WS_Q = 816 * MiB;
constexpr size_t WS_KALL = 976 * MiB;
constexpr size_t WS_VALL = 1112 * MiB;
constexpr size_t WS_KC = 1248 * MiB;
constexpr size_t WS_VC = 1280 * MiB;
constexpr size_t WS_ATTS = 1312 * MiB;
constexpr size_t WS_SSQ = 1376 * MiB;
constexpr size_t WS_SW = 1381 * MiB;
constexpr size_t WS_END = 1384 * MiB;
constexpr int SW_G1_L = 9 * 2 * FFH, SW_SGU = 4 * SW_G1_L, SW_QKV = SW_SGU + 9 * 4096, SW_TOTAL = SW_QKV + 9 * 6144;
static_assert((size_t)SW_TOTAL * 4 <= 2 * MiB, "shift@W tables");
constexpr size_t FFNIN_L = (size_t)2 * FFH * DM * 2, FFNOUT_L = (size_t)DM * FFH * 2;

constexpr int CW_BAR = 4096;

constexpr int RING_BYTES = 131072;
constexpr int LDS_BYTES = 163840;
constexpr int LDSCTL_OFF = LDS_BYTES - 256, MISC_OFF = LDSCTL_OFF;
constexpr int RT_OFF = RING_BYTES, TAB_FLOATS = 512, SSX_FLOATS = 1024, STG_FLOAT_OFF = 2 * 512 + 2 * 1024;
constexpr int RT_DOC = 0;

constexpr int NPH = 22;
__host__ __device__ inline bool phase_nonempty(int p) { return !(p == 3 || p == 18); }

__device__ __forceinline__ unsigned cvt_pk_bf16(float lo, float hi) { unsigned r; asm volatile("v_cvt_pk_bf16_f32 %0, %1, %2" : "=v"(r) : "v"(lo), "v"(hi)); return r; }
__device__ __forceinline__ f32x4 bf4_to_f4(u32x2 d) { return (f32x4){__uint_as_float(d.x << 16), __uint_as_float(d.x & 0xffff0000u), __uint_as_float(d.y << 16), __uint_as_float(d.y & 0xffff0000u)}; }
typedef _Float16 h16x2 __attribute__((ext_vector_type(2)));
typedef _Float16 h16x4 __attribute__((ext_vector_type(4)));
__device__ __forceinline__ unsigned pk_f16(float a, float b) { const h16x2 h = __builtin_convertvector((f32x2){a, b}, h16x2); return __builtin_bit_cast(unsigned, h); }
__device__ __forceinline__ f32x4 h4_to_f4(u32x2 d) { const h16x4 h = __builtin_bit_cast(h16x4, d); return __builtin_convertvector(h, f32x4); }
__device__ __forceinline__ float bf2f(bf16_t b) { return __uint_as_float(((unsigned)b) << 16); }
__device__ __forceinline__ bf16_t f2bf(float f) { return (bf16_t)(cvt_pk_bf16(f, 0.f) & 0xffffu); }
__device__ __forceinline__ int opaque_tid() { int t = threadIdx.x; asm volatile("" : "+v"(t)); return t; }
__device__ __forceinline__ float add_xor1(float x) { return x + __builtin_bit_cast(float, __builtin_amdgcn_update_dpp(0, __builtin_bit_cast(int, x), 0xB1, 0xF, 0xF, true)); }
__device__ __forceinline__ float add_xor2(float x) { return x + __builtin_bit_cast(float, __builtin_amdgcn_update_dpp(0, __builtin_bit_cast(int, x), 0x4E, 0xF, 0xF, true)); }
__device__ __forceinline__ float add_xor16(float x) { return x + __builtin_bit_cast(float, __builtin_amdgcn_ds_swizzle(__builtin_bit_cast(int, x), 0x401F)); }
__device__ __forceinline__ float add_xor32(float x) { auto r = __builtin_amdgcn_permlane32_swap(__builtin_bit_cast(unsigned, x), __builtin_bit_cast(unsigned, x), false, false); return __uint_as_float(r[0]) + __uint_as_float(r[1]); }
__device__ __forceinline__ float wave_sum(float v) {
    v = add_xor1(v); v = add_xor2(v);
    v += __builtin_bit_cast(float, __builtin_amdgcn_update_dpp(0, __builtin_bit_cast(int, v), 0x141, 0xF, 0xF, true));
    v += __builtin_bit_cast(float, __builtin_amdgcn_update_dpp(0, __builtin_bit_cast(int, v), 0x140, 0xF, 0xF, true));
    v = add_xor16(v); return add_xor32(v);
}
__device__ __forceinline__ float dot4(f32x4 a) { return (a.x * a.x + a.y * a.y) + (a.z * a.z + a.w * a.w); }

namespace pg8 {
constexpr int BM = 256, BK = 64, HALF = 128, HTB = HALF * BK * 2, STAGE_BYTES = 8 * HTB, NXCD = 8;
__host__ __device__ __forceinline__ int lds_byte(int r, int c) { const int st = (r >> 4) * 2 + (c >> 5), rr = r & 15, cc = c & 31, ob = rr * 64 + cc * 2; return st * 1024 + (ob ^ (((ob >> 9) & 1) << 5)); }
__host__ __device__ __forceinline__ void stage_rc(int b, int& R, int& C) { const int st = b / 1024, sb = b % 1024, swz = sb ^ (((sb >> 9) & 1) << 5); R = (st >> 1) * 16 + swz / 64; C = (st & 1) * 32 + (swz % 64) / 2; }
__host__ __device__ __forceinline__ int perm32(int rho) { const int n = rho >> 4, i = rho & 15; return 8 * (i >> 2) + 4 * n + (i & 3); }

struct Unit { int pm, pn; };
struct Gemm { const bf16_t* A; const bf16_t* Bt; int lda, K, agrp; unsigned kstepA; size_t tstepA; };
__host__ __device__ __forceinline__ Gemm mk_gemm(const bf16_t* A, const bf16_t* Bt, int lda, int K, int agrp = 0) { return Gemm{A, Bt, lda, K, agrp, (unsigned)(BK * 2), (size_t)BM * lda * 2}; }

struct StaticOrder {
    int nM, nN, nwg, G, c, WGM, rev;
    __host__ __device__ void init(int M, int N, int G_, int c_, int wgm = 8, int rev_ = 0) { nM = M / BM; nN = N / BM; nwg = nM * nN; G = G_; c = c_; WGM = wgm; rev = rev_; }
    __host__ __device__ bool next(int i, Unit& u) const {
        const long L = (long)i * G + c; if (L >= nwg) return false;
        int wgid = (int)L; { const int q = nwg / NXCD, r = nwg % NXCD, xcd = wgid % NXCD, off = wgid / NXCD; wgid = (xcd < r ? xcd * (q + 1) : r * (q + 1) + (xcd - r) * q) + off; }
        const int nig = WGM * nN, gid = wgid / nig, fm = gid * WGM, gsz = (nM - fm) < WGM ? (nM - fm) : WGM;
        u.pm = fm + ((wgid % nig) % gsz); u.pn = (wgid % nig) / gsz; if (rev) u.pm = nM - 1 - u.pm; return true;
    }
};

__device__ __forceinline__ f32x2 gelu_pk(f32x2 v) {
    const f32x2 av = __builtin_elementwise_abs(v), d = av * 0.2316418882f + 1.0f;
    f32x2 t; t.x = __builtin_amdgcn_rcpf(d.x); t.y = __builtin_amdgcn_rcpf(d.y);
    f32x2 q = t * 0.5307027145f + (-0.7265760135f); q = q * t + 0.7107068705f; q = q * t + (-0.142248368f); q = q * t + 0.127414796f; q = q * t;
    const f32x2 s = (v * v) * (-0.72134752044f);
    f32x2 e; e.x = __builtin_amdgcn_exp2f(s.x); e.y = __builtin_amdgcn_exp2f(s.y);
    const f32x2 m = v * (q * e), r = v - m;
    f32x2 o; o.x = v.x < 0.f ? m.x : r.x; o.y = v.y < 0.f ? m.y : r.y; return o;
}

__device__ __forceinline__ int ci_of_pm(int pm) { return pm < 32 ? 8 : ((pm - 32) >> 4); }


struct EpiRes {
    static constexpr bool PERM = true, HAS_PREF = true;
    const float* xin0; const float* xin1;
    const bf16_t* xin16;
    bf16_t* xout; const float* gate;
    const float* cscale;
    float* ssq; bf16_t* xg; const float* gnext; const float* scnext;
    __device__ __forceinline__ void pref_direct(const Unit& u, LAS float* tab, int tid) const {
        if (tid < 64) { const int ci = ci_of_pm(u.pm), c4 = u.pn * BM + tid * 4; f32x4 g = *(const f32x4*)(gate + (size_t)ci * NMOD + c4);
            if (cscale) g = g * *(const f32x4*)(cscale + c4);
            *(LAS f32x4*)(tab + tid * 4) = g;
            if (xg) *(LAS f32x4*)(tab + 256 + tid * 4) = *(const f32x4*)(gnext + c4) * (*(const f32x4*)(scnext + (size_t)ci * NMOD + c4) + 1.0f); }
    }
    __device__ __forceinline__ void pref_dma(const Unit& u, LAS float* stg, int wid, int lane) const {
        const int ci = ci_of_pm(u.pm), c4 = u.pn * BM + lane * 4, v = wid & 3;
        const float* gsrc = gate + (size_t)ci * NMOD;
        const float* src = (v == 0) ? gsrc : (v == 1) ? (cscale ? cscale : gsrc) : (v == 2) ? (xg ? gnext : gsrc) : (xg ? scnext + (size_t)ci * NMOD : gsrc);
        __builtin_amdgcn_global_load_lds((const unsigned*)(src + c4), (LAS unsigned*)(stg + v * 256), 16, 0, 0);
    }
    __device__ __forceinline__ void pref_commit(const LAS float* stg, LAS float* tab, int tid) const {
        if (tid < 64) { f32x4 g = *(const LAS f32x4*)(stg + tid * 4); if (cscale) g = g * *(const LAS f32x4*)(stg + 256 + tid * 4);
            *(LAS f32x4*)(tab + tid * 4) = g;
            if (xg) *(LAS f32x4*)(tab + 256 + tid * 4) = *(const LAS f32x4*)(stg + 512 + tid * 4) * (*(const LAS f32x4*)(stg + 768 + tid * 4) + 1.0f); }
    }
    __device__ __forceinline__ void operator()(const f32x4 (&acc)[2][2][4][2], const Unit& u, int wr, int wc, int fr, int fq, const LAS float* tab, LAS float* ssx) const {
        const int row0 = u.pm * BM + wr * 64 + fr, col0 = u.pn * BM + wc * 32 + 8 * fq;
        const LAS float* tg = tab + wc * 32 + 8 * fq;
        const float* xb = (u.pm < 32) ? xin0 : xin1; const int radj = (u.pm < 32) ? 0 : NCTX;
#define RES_BODY(ai, m0, NM, XLOAD0, XLOAD1) \
            _Pragma("unroll") for (int m_ = 0; m_ < NM; ++m_) { const int m = (m0) + m_; const int row = row0 + (ai) * HALF + m * 16; bf16_t* xo = xout + (size_t)row * DM + col0; float ss = 0.f; \
                _Pragma("unroll") for (int bj = 0; bj < 2; ++bj) { const f32x4 g0 = *(const LAS f32x4*)(tg + bj * HALF), g1 = *(const LAS f32x4*)(tg + bj * HALF + 4); \
                    const f32x4 x0 = (XLOAD0) + g0 * acc[ai][bj][m][0], x1 = (XLOAD1) + g1 * acc[ai][bj][m][1]; \
                    { u32x4 w; w.x = pk_f16(x0[0], x0[1]); w.y = pk_f16(x0[2], x0[3]); w.z = pk_f16(x1[0], x1[1]); w.w = pk_f16(x1[2], x1[3]); *(u32x4*)(xo + bj * HALF) = w; } \
                    ss += dot4(x0) + dot4(x1); \
                    if (xg) { const f32x4 h0 = x0 * *(const LAS f32x4*)(tg + 256 + bj * HALF), h1 = x1 * *(const LAS f32x4*)(tg + 256 + bj * HALF + 4); \
                        u32x4 w; w.x = cvt_pk_bf16(h0[0], h0[1]); w.y = cvt_pk_bf16(h0[2], h0[3]); w.z = cvt_pk_bf16(h1[0], h1[1]); w.w = cvt_pk_bf16(h1[2], h1[3]); \
                        *(u32x4*)(xg + (size_t)row * DM + col0 + bj * HALF) = w; } } \
                if (ssq) { ss = add_xor16(ss); ss = add_xor32(ss); if (fq == 0) ssx[((ai) * HALF + wr * 64 + m * 16 + fr) * 4 + wc] = ss; } }
#define RES_ROWS32(ai, m0, NM) do { f32x4 xv[NM][2][2]; \
            _Pragma("unroll") for (int m_ = 0; m_ < NM; ++m_) { const float* xr = xb + (size_t)(row0 + (ai) * HALF + ((m0) + m_) * 16 - radj) * DM + col0; \
                _Pragma("unroll") for (int bj = 0; bj < 2; ++bj) _Pragma("unroll") for (int n = 0; n < 2; ++n) xv[m_][bj][n] = *(const f32x4*)(xr + bj * HALF + n * 4); } \
            RES_BODY(ai, m0, NM, xv[m_][bj][0], xv[m_][bj][1]) } while (0)
#define RES_ROWS16(ai, m0, NM) do { u32x4 xv[NM][2]; \
            _Pragma("unroll") for (int m_ = 0; m_ < NM; ++m_) { const bf16_t* xr = xin16 + (size_t)(row0 + (ai) * HALF + ((m0) + m_) * 16) * DM + col0; \
                _Pragma("unroll") for (int bj = 0; bj < 2; ++bj) xv[m_][bj] = *(const u32x4*)(xr + bj * HALF); } \
            RES_BODY(ai, m0, NM, h4_to_f4((u32x2){xv[m_][bj].x, xv[m_][bj].y}), h4_to_f4((u32x2){xv[m_][bj].z, xv[m_][bj].w})) } while (0)
        if (xin16) { RES_ROWS16(0, 0, 4); RES_ROWS16(1, 0, 4); }
        else { RES_ROWS32(0, 0, 4); RES_ROWS32(1, 0, 4); }
#undef RES_ROWS32
#undef RES_ROWS16
#undef RES_BODY
    }
    __device__ __forceinline__ void post(const Unit& u, const LAS float* ssx, int tid) const {
        if (ssq && tid < 256) { const f32x4 v = *(const LAS f32x4*)(ssx + tid * 4); int t4 = tid; asm volatile("" : "+v"(t4)); *(float*)((char*)(ssq + (size_t)u.pm * BM * 8 + u.pn) + (unsigned)t4 * 32u) = (v.x + v.y) + (v.z + v.w); }
    }
};

struct EpiDelta {
    static constexpr bool PERM = true, HAS_PREF = false;
    bf16_t* D; const float* gate; const float* cscale;
    __device__ __forceinline__ void pref_direct(const Unit&, LAS float*, int) const {}
    __device__ __forceinline__ void pref_dma(const Unit&, LAS float*, int, int) const {}
    __device__ __forceinline__ void pref_commit(const LAS float*, LAS float*, int) const {}
    __device__ __forceinline__ void post(const Unit&, const LAS float*, int) const {}
    __device__ __forceinline__ void operator()(const f32x4 (&acc)[2][2][4][2], const Unit& u, int wr, int wc, int fr, int fq, const LAS float*, LAS float*) const {
        const int ci = ci_of_pm(u.pm);
        const float* gp = gate + (size_t)ci * NMOD;
        const int row0 = u.pm * BM + wr * 64 + fr, col0 = u.pn * BM + wc * 32 + 8 * fq;
        f32x4 gv[2][2];
#pragma unroll
        for (int bj = 0; bj < 2; ++bj)
#pragma unroll
            for (int n = 0; n < 2; ++n) { gv[bj][n] = *(const f32x4*)(gp + col0 + bj * HALF + n * 4); if (cscale) gv[bj][n] = gv[bj][n] * *(const f32x4*)(cscale + col0 + bj * HALF + n * 4); }
#pragma unroll
        for (int ai = 0; ai < 2; ++ai)
#pragma unroll
            for (int m = 0; m < 4; ++m) { bf16_t* rowp = D + (size_t)(row0 + ai * HALF + m * 16) * DM + col0;
#pragma unroll
                for (int bj = 0; bj < 2; ++bj) { const f32x4 v0 = acc[ai][bj][m][0] * gv[bj][0], v1 = acc[ai][bj][m][1] * gv[bj][1];
                    u32x4 w; w.x = cvt_pk_bf16(v0[0], v0[1]); w.y = cvt_pk_bf16(v0[2], v0[3]); w.z = cvt_pk_bf16(v1[0], v1[1]); w.w = cvt_pk_bf16(v1[2], v1[3]);
                    *(u32x4*)(rowp + bj * HALF) = w; } }
    }
};

__device__ __forceinline__ void cons_pref_direct(const float* ssq, const float* sw, int N, const Unit& u, LAS float* tab, int tid) {
    const f32x4 part = *(const f32x4*)(ssq + ((size_t)u.pm * BM + (tid >> 1)) * 8 + (tid & 1) * 4);
    const float s_ = add_xor1((part.x + part.y) + (part.z + part.w));
    if ((tid & 1) == 0) tab[tid >> 1] = 1.0f / sqrtf(s_ * (1.0f / DM) + EPS);
    if (tid < 64) *(LAS f32x4*)(tab + 256 + tid * 4) = *(const f32x4*)(sw + (size_t)ci_of_pm(u.pm) * N + u.pn * BM + tid * 4);
}
__device__ __forceinline__ void cons_pref_dma(const float* ssq, const float* sw, int N, const Unit& u, LAS float* stg, int wid, int lane) {
    __builtin_amdgcn_global_load_lds((const unsigned*)(ssq + ((size_t)u.pm * BM + wid * 32) * 8 + lane * 4), (LAS unsigned*)(stg + wid * 256), 16, 0, 0);
    __builtin_amdgcn_global_load_lds((const unsigned*)(sw + (size_t)ci_of_pm(u.pm) * N + u.pn * BM + lane * 4), (LAS unsigned*)(stg + 2048), 16, 0, 0);
}
__device__ __forceinline__ void cons_pref_commit(const LAS float* stg, LAS float* tab, int tid) {
    const f32x4 part = *(const LAS f32x4*)(stg + (tid >> 1) * 8 + (tid & 1) * 4);
    const float s_ = add_xor1((part.x + part.y) + (part.z + part.w));
    if ((tid & 1) == 0) tab[tid >> 1] = 1.0f / sqrtf(s_ * (1.0f / DM) + EPS);
    if (tid < 64) *(LAS f32x4*)(tab + 256 + tid * 4) = *(const LAS f32x4*)(stg + 2048 + tid * 4);
}

struct EpiSwiglu {
    static constexpr bool PERM = true, HAS_PREF = true;
    bf16_t* O;
    const float* ssq;
    const float* sw;
    __device__ __forceinline__ void pref_direct(const Unit& u, LAS float* tab, int tid) const { cons_pref_direct(ssq, sw, 2 * FFH, u, tab, tid); }
    __device__ __forceinline__ void pref_dma(const Unit& u, LAS float* stg, int wid, int lane) const { cons_pref_dma(ssq, sw, 2 * FFH, u, stg, wid, lane); }
    __device__ __forceinline__ void pref_commit(const LAS float* stg, LAS float* tab, int tid) const { cons_pref_commit(stg, tab, tid); }
    __device__ __forceinline__ void post(const Unit&, const LAS float*, int) const {}
    __device__ __forceinline__ void operator()(const f32x4 (&acc)[2][2][4][2], const Unit& u, int wr, int wc, int fr, int fq, const LAS float* rt, LAS float*) const {
        bf16_t* blk = O + ((size_t)(u.pm * (FFH / 64) + 2 * u.pn + (wc >> 1)) * 256 + wr * 64 + fr) * 64 + (wc & 1) * 32 + 8 * fq;
        const LAS float* swp = rt + 256 + wc * 32 + 8 * fq;
        f32x4 sa[2], sb[2];
#pragma unroll
        for (int n = 0; n < 2; ++n) { sa[n] = *(const LAS f32x4*)(swp + 4 * n); sb[n] = *(const LAS f32x4*)(swp + HALF + 4 * n); }
#pragma unroll
        for (int ai = 0; ai < 2; ++ai)
#pragma unroll
            for (int m = 0; m < 4; ++m) { bf16_t* rowp = blk + (size_t)(ai * HALF + m * 16) * 64; const float rs = rt[ai * HALF + wr * 64 + m * 16 + fr];
                f32x4 r[2];
#pragma unroll
                for (int n = 0; n < 2; ++n) {
                    const f32x4 a = acc[ai][0][m][n] * rs + sa[n], b = acc[ai][1][m][n] * rs + sb[n];
                    const f32x4 e = a * -1.4426950408889634f;
                    f32x4 d; d.x = __builtin_amdgcn_exp2f(e.x); d.y = __builtin_amdgcn_exp2f(e.y); d.z = __builtin_amdgcn_exp2f(e.z); d.w = __builtin_amdgcn_exp2f(e.w);
                    d = d + 1.0f;
                    f32x4 sg; sg.x = __builtin_amdgcn_rcpf(d.x); sg.y = __builtin_amdgcn_rcpf(d.y); sg.z = __builtin_amdgcn_rcpf(d.z); sg.w = __builtin_amdgcn_rcpf(d.w);
                    r[n] = (a * b) * sg; }
                u32x4 w; w.x = cvt_pk_bf16(r[0].x, r[0].y); w.y = cvt_pk_bf16(r[0].z, r[0].w); w.z = cvt_pk_bf16(r[1].x, r[1].y); w.w = cvt_pk_bf16(r[1].z, r[1].w);
                *(u32x4*)rowp = w; }
    }
};

struct EpiGelu {
    static constexpr bool PERM = true, HAS_PREF = true;
    bf16_t* Z; float* vss; const float* ssq; const float* sw;
    __device__ __forceinline__ void pref_direct(const Unit& u, LAS float* tab, int tid) const { cons_pref_direct(ssq, sw, 4096, u, tab, tid); }
    __device__ __forceinline__ void pref_dma(const Unit& u, LAS float* stg, int wid, int lane) const { cons_pref_dma(ssq, sw, 4096, u, stg, wid, lane); }
    __device__ __forceinline__ void pref_commit(const LAS float* stg, LAS float* tab, int tid) const { cons_pref_commit(stg, tab, tid); }
    __device__ __forceinline__ void post(const Unit&, const LAS float*, int) const {}
    __device__ __forceinline__ void operator()(const f32x4 (&acc)[2][2][4][2], const Unit& u, int wr, int wc, int fr, int fq, const LAS float* rt, LAS float*) const {
        const int row0 = u.pm * BM + wr * 64 + fr, col0 = u.pn * BM + wc * 32 + 8 * fq;
        const LAS float* swp = rt + 256 + wc * 32 + 8 * fq;
        f32x4 sv[2][2];
#pragma unroll
        for (int bj = 0; bj < 2; ++bj)
#pragma unroll
            for (int n = 0; n < 2; ++n) sv[bj][n] = *(const LAS f32x4*)(swp + bj * HALF + 4 * n);
#pragma unroll
        for (int ai = 0; ai < 2; ++ai)
#pragma unroll
            for (int m = 0; m < 4; ++m) { const int row = row0 + ai * HALF + m * 16; bf16_t* rowp = Z + (size_t)row * 4096 + col0; float ss = 0.f; const float rs = rt[ai * HALF + wr * 64 + m * 16 + fr];
#pragma unroll
                for (int bj = 0; bj < 2; ++bj) { const f32x4 v0 = acc[ai][bj][m][0] * rs + sv[bj][0], v1 = acc[ai][bj][m][1] * rs + sv[bj][1];
                    const f32x2 a = gelu_pk((f32x2){v0[0], v0[1]}), b = gelu_pk((f32x2){v0[2], v0[3]}), c = gelu_pk((f32x2){v1[0], v1[1]}), d = gelu_pk((f32x2){v1[2], v1[3]});
                    ss += (a.x * a.x + a.y * a.y) + (b.x * b.x + b.y * b.y) + (c.x * c.x + c.y * c.y) + (d.x * d.x + d.y * d.y);
                    u32x4 w; w.x = cvt_pk_bf16(a.x, a.y); w.y = cvt_pk_bf16(b.x, b.y); w.z = cvt_pk_bf16(c.x, c.y); w.w = cvt_pk_bf16(d.x, d.y);
                    *(u32x4*)(rowp + bj * HALF) = w; }
                if (u.pn >= 8) { ss = add_xor16(ss); ss = add_xor32(ss); if (fq == 0) vss[(size_t)row * 32 + (u.pn - 8) * 4 + wc] = ss; } }
    }
};

struct EpiQKV {
    static constexpr bool PERM = true, HAS_PREF = true;
    bf16_t *Q, *Kall, *Vall, *Kc, *Vc; float *outk, *outv; const float* rope;
    const float* ssq; const float* sw;
    __device__ __forceinline__ void pref_direct(const Unit& u, LAS float* tab, int tid) const { cons_pref_direct(ssq, sw, 6144, u, tab, tid); }
    __device__ __forceinline__ void pref_dma(const Unit& u, LAS float* stg, int wid, int lane) const { cons_pref_dma(ssq, sw, 6144, u, stg, wid, lane); }
    __device__ __forceinline__ void pref_commit(const LAS float* stg, LAS float* tab, int tid) const { cons_pref_commit(stg, tab, tid); }
    __device__ __forceinline__ void post(const Unit&, const LAS float*, int) const {}
    __device__ __forceinline__ void operator()(f32x4 (&acc)[2][2][4][2], const Unit& u, int wr, int wc, int fr, int fq, const LAS float* rt, LAS float*) const {
        { const LAS float* swp = rt + 256 + wc * 32 + 8 * fq;
          f32x4 sv[2][2];
#pragma unroll
          for (int bj = 0; bj < 2; ++bj)
#pragma unroll
              for (int n = 0; n < 2; ++n) sv[bj][n] = *(const LAS f32x4*)(swp + bj * HALF + 4 * n);
#pragma unroll
          for (int ai = 0; ai < 2; ++ai)
#pragma unroll
              for (int m = 0; m < 4; ++m) { const float rs = rt[ai * HALF + wr * 64 + m * 16 + fr];
#pragma unroll
                  for (int bj = 0; bj < 2; ++bj)
#pragma unroll
                      for (int n = 0; n < 2; ++n) acc[ai][bj][m][n] = acc[ai][bj][m][n] * rs + sv[bj][n]; } }
        const bool ctx = u.pm < 32;
        const int row0 = u.pm * BM + wr * 64 + fr;
        const int lb = ctx ? 0 : ((u.pm - 32) >> 4);
        if (u.pn < 16) {
            const int sec = u.pn >> 3, h = u.pn & 7, mp = wc >> 1, axis = wc & 1;
            const int nat0 = h * 256 + mp * 128 + axis * 64 + 8 * fq;
            if (ctx) {
                bf16_t* dst = sec ? Kc : Q;
#pragma unroll
                for (int ai = 0; ai < 2; ++ai)
#pragma unroll
                    for (int m = 0; m < 4; ++m) { const int row = row0 + ai * HALF + m * 16;
#pragma unroll
                        for (int bj = 0; bj < 2; ++bj) { const f32x4 v0 = acc[ai][bj][m][0], v1 = acc[ai][bj][m][1]; const size_t o = (size_t)row * DM + nat0 + bj * 32;
                            u32x4 w; w.x = cvt_pk_bf16(v0[0], v0[1]); w.y = cvt_pk_bf16(v0[2], v0[3]); w.z = cvt_pk_bf16(v1[0], v1[1]); w.w = cvt_pk_bf16(v1[2], v1[3]);
                            *(u32x4*)(dst + o) = w;
                            if (sec) { *(f32x4*)(outk + o) = v0; *(f32x4*)(outk + o + 4) = v1; } } }
            } else {
#pragma unroll
                for (int am = 0; am < 4; ++am) { const int ai = am >> 1, mb = (am & 1) * 2;
                    f32x4 cs[2][4];
#pragma unroll
                    for (int m_ = 0; m_ < 2; ++m_) { const int row = row0 + ai * HALF + (mb + m_) * 16; const int t = (row - NCTX) & (LATSEQ - 1); const int pos = axis ? (t & 63) : (t >> 6);
                        const f32x4* rp = (const f32x4*)(rope + (size_t)(pos * 32 + 8 * fq) * 2);
#pragma unroll
                        for (int j = 0; j < 4; ++j) cs[m_][j] = rp[j]; }
#pragma unroll
                    for (int m_ = 0; m_ < 2; ++m_) { const int m = mb + m_; const int row = row0 + ai * HALF + m * 16; const int t = (row - NCTX) & (LATSEQ - 1);
                        const float cc[8] = {cs[m_][0][0], cs[m_][0][2], cs[m_][1][0], cs[m_][1][2], cs[m_][2][0], cs[m_][2][2], cs[m_][3][0], cs[m_][3][2]};
                        const float sn[8] = {cs[m_][0][1], cs[m_][0][3], cs[m_][1][1], cs[m_][1][3], cs[m_][2][1], cs[m_][2][3], cs[m_][3][1], cs[m_][3][3]};
                        float o1[8], o2[8];
#pragma unroll
                        for (int n = 0; n < 2; ++n)
#pragma unroll
                            for (int i = 0; i < 4; ++i) { const float x1 = acc[ai][0][m][n][i], x2 = acc[ai][1][m][n][i]; const float c = cc[n * 4 + i], sv = sn[n * 4 + i];
                                o1[n * 4 + i] = x1 * c - x2 * sv; o2[n * 4 + i] = x2 * c + x1 * sv; }
                        bf16_t* dp = sec ? (Kall + ((size_t)lb * KVLEN + PAST + t) * DM + nat0) : (Q + (size_t)row * DM + nat0);
                        u32x4 w; w.x = cvt_pk_bf16(o1[0], o1[1]); w.y = cvt_pk_bf16(o1[2], o1[3]); w.z = cvt_pk_bf16(o1[4], o1[5]); w.w = cvt_pk_bf16(o1[6], o1[7]);
                        *(u32x4*)dp = w;
                        w.x = cvt_pk_bf16(o2[0], o2[1]); w.y = cvt_pk_bf16(o2[2], o2[3]); w.z = cvt_pk_bf16(o2[4], o2[5]); w.w = cvt_pk_bf16(o2[6], o2[7]);
                        *(u32x4*)(dp + 32) = w; }
                }
            }
        } else {
            const int col0 = (u.pn - 16) * BM + wc * 32 + 8 * fq;
#pragma unroll
            for (int ai = 0; ai < 2; ++ai)
#pragma unroll
                for (int m = 0; m < 4; ++m) { const int row = row0 + ai * HALF + m * 16; const int t = (row - NCTX) & (LATSEQ - 1);
                    bf16_t* dp = ctx ? (Vc + (size_t)row * DM + col0) : (Vall + ((size_t)lb * KVLEN + PAST + t) * DM + col0);
#pragma unroll
                    for (int bj = 0; bj < 2; ++bj) { const f32x4 v0 = acc[ai][bj][m][0], v1 = acc[ai][bj][m][1];
                        u32x4 w; w.x = cvt_pk_bf16(v0[0], v0[1]); w.y = cvt_pk_bf16(v0[2], v0[3]); w.z = cvt_pk_bf16(v1[0], v1[1]); w.w = cvt_pk_bf16(v1[2], v1[3]);
                        *(u32x4*)(dp + bj * HALF) = w;
                        if (ctx) { float* op = outv + (size_t)row * DM + col0 + bj * HALF; *(f32x4*)op = v0; *(f32x4*)(op + 4) = v1; } } }
        }
    }
};

template <class Epi, class Sched>
__device__ __forceinline__ void gemm_phase(LAS unsigned char* lds, const Gemm g, const Sched& S, const Epi& E) {
    const int tid = opaque_tid(), wid = __builtin_amdgcn_readfirstlane(tid >> 6), lane = tid & 63, wr = wid >> 2, wc = wid & 3, fr = lane & 15, fq = lane >> 4;
    const int K = g.K, nt = K / BK, lda = g.lda;
    unsigned voffA[2], voffB[2];
#pragma unroll
    for (int i = 0; i < 2; ++i) { int R, C; stage_rc(tid * 16 + i * 8192, R, C); const int Rb = Epi::PERM ? ((R & ~31) + perm32(R & 31)) : R;
        voffA[i] = (unsigned)(R * lda + C) * 2u; voffB[i] = (unsigned)(Rb * K + C) * 2u; }
    const size_t kstep = (size_t)(BK * 2), kstepA = g.kstepA;
    const size_t hstepA = (size_t)HALF * lda * 2, hstepB = (size_t)HALF * K * 2;
    const unsigned ldsw = (unsigned)wid * 1024u;
    const int aoff = lds_byte(wr * 64 + fr, fq * 8), boff = lds_byte(wc * 32 + fr, fq * 8);
#define PG8_SA(b, h) (((b) * 2 + (h)) * HTB)
#define PG8_SB(b, h) ((4 + (b) * 2 + (h)) * HTB)
#define PG8_STAGE(bufoff, gbase, voff) do { _Pragma("unroll") for (int _i = 0; _i < 2; ++_i) \
        __builtin_amdgcn_global_load_lds((const unsigned*)((const char*)(gbase) + (voff)[_i]), (LAS unsigned*)(lds + (bufoff) + ldsw + _i * 8192), 16, 0, 0); } while (0)
#define PG8_LDA(dst, b, h) do { _Pragma("unroll") for (int m = 0; m < 4; ++m) _Pragma("unroll") for (int k = 0; k < 2; ++k) dst[m][k] = *(const LAS bf16x8*)(lds + PG8_SA(b, h) + aoff + m * 2048 + k * 1024); } while (0)
#define PG8_LDB(dst, b, h) do { _Pragma("unroll") for (int n = 0; n < 2; ++n) _Pragma("unroll") for (int k = 0; k < 2; ++k) dst[n][k] = *(const LAS bf16x8*)(lds + PG8_SB(b, h) + boff + n * 2048 + k * 1024); } while (0)
#define PG8_MMA(ai, bj, At, Bt) do { __builtin_amdgcn_s_setprio(1); _Pragma("unroll") for (int m = 0; m < 4; ++m) _Pragma("unroll") for (int n = 0; n < 2; ++n) _Pragma("unroll") for (int k = 0; k < 2; ++k) \
        acc[ai][bj][m][n] = __builtin_amdgcn_mfma_f32_16x16x32_bf16(Bt[n][k], At[m][k], acc[ai][bj][m][n], 0, 0, 0); __builtin_amdgcn_s_setprio(0); } while (0)
#define PG8_WAIT_V(n) asm volatile("s_waitcnt vmcnt(" #n ")" ::: "memory")
#define PG8_WAIT_L(n) asm volatile("s_waitcnt lgkmcnt(" #n ")" ::: "memory")
#define PG8_BAR __builtin_amdgcn_s_barrier()
#define PG8_SCHED __builtin_amdgcn_sched_barrier(0)
    Unit cur, nxt, prv; int ui = 0;
    if (!S.next(0, cur)) return;
    prv = cur;
    LAS float* TAB = (LAS float*)(lds + RT_OFF);
    LAS float* STG = TAB + STG_FLOAT_OFF;
    if constexpr (Epi::HAS_PREF) E.pref_direct(cur, TAB, tid);
    f32x4 acc[2][2][4][2];
#pragma unroll
    for (int a = 0; a < 2; ++a)
#pragma unroll
        for (int b = 0; b < 2; ++b)
#pragma unroll
            for (int m = 0; m < 4; ++m)
#pragma unroll
                for (int n = 0; n < 2; ++n) acc[a][b][m][n] = (f32x4){0.f, 0.f, 0.f, 0.f};
    bf16x8 At[4][2], B0[2][2], B1[2][2];
    const char* cA = (const char*)g.A + (size_t)cur.pm * g.tstepA + (size_t)(cur.pn >> 1) * g.agrp * 2; const char* cB = (const char*)g.Bt + (size_t)cur.pn * 2 * hstepB;
    PG8_STAGE(PG8_SB(0, 0), cB, voffB); PG8_STAGE(PG8_SB(0, 1), cB + hstepB, voffB); PG8_STAGE(PG8_SA(0, 0), cA, voffA); PG8_STAGE(PG8_SA(0, 1), cA + hstepA, voffA);
    if (wr == 1) PG8_BAR;
    PG8_WAIT_V(2); PG8_BAR;
    PG8_STAGE(PG8_SB(1, 0), cB + kstep, voffB); PG8_STAGE(PG8_SA(1, 0), cA + kstepA, voffA); PG8_STAGE(PG8_SB(1, 1), cB + hstepB + kstep, voffB);
    PG8_WAIT_V(6); PG8_BAR;
    for (;;) {
        const bool has_next = S.next(ui + 1, nxt);
        const char* nA = has_next ? (const char*)g.A + (size_t)nxt.pm * g.tstepA + (size_t)(nxt.pn >> 1) * g.agrp * 2 : cA; const char* nB = has_next ? (const char*)g.Bt + (size_t)nxt.pn * 2 * hstepB : cB;
        for (int t = 0; t < nt; t += 2) {
            const bool last = (t == nt - 2);
            if constexpr (Epi::HAS_PREF) { if (last && has_next) E.pref_dma(nxt, STG, wid, lane); }
            const char* a1 = cA + (size_t)(t + 1) * kstepA;
            const char* a2 = last ? nA : cA + (size_t)(t + 2) * kstepA; const char* b2 = last ? nB : cB + (size_t)(t + 2) * kstep;
            const char* a3 = a2 + kstepA; const char* b3 = b2 + kstep;
            PG8_LDB(B0, 0, 0); PG8_LDB(B1, 0, 1); PG8_SCHED; PG8_LDA(At, 0, 0); PG8_STAGE(PG8_SA(1, 1), a1 + hstepA, voffA);
            PG8_WAIT_V(8); PG8_WAIT_L(0); PG8_BAR; PG8_MMA(0, 0, At, B0); PG8_MMA(0, 1, At, B1); PG8_BAR; PG8_SCHED;
            PG8_LDA(At, 0, 1); PG8_STAGE(PG8_SB(0, 0), b2, voffB); PG8_STAGE(PG8_SB(0, 1), b2 + hstepB, voffB); PG8_STAGE(PG8_SA(0, 0), a2, voffA);
            PG8_WAIT_V(8); PG8_WAIT_L(0); PG8_BAR; PG8_MMA(1, 0, At, B0); PG8_MMA(1, 1, At, B1); PG8_BAR; PG8_SCHED;
            PG8_LDB(B0, 1, 0); PG8_LDB(B1, 1, 1); PG8_SCHED; PG8_LDA(At, 1, 0); PG8_STAGE(PG8_SA(0, 1), a2 + hstepA, voffA);
            PG8_WAIT_V(8); PG8_WAIT_L(0); PG8_BAR; PG8_MMA(0, 0, At, B0); PG8_MMA(0, 1, At, B1); PG8_BAR; PG8_SCHED;
            PG8_LDA(At, 1, 1); PG8_STAGE(PG8_SB(1, 0), b3, voffB); PG8_STAGE(PG8_SB(1, 1), b3 + hstepB, voffB); PG8_STAGE(PG8_SA(1, 0), a3, voffA);
            PG8_WAIT_V(8); PG8_WAIT_L(0); PG8_BAR; PG8_MMA(1, 0, At, B0); PG8_MMA(1, 1, At, B1); PG8_BAR; PG8_SCHED;
        }
        if (wr == 0) PG8_BAR;
        if (ui > 0) E.post(prv, TAB + 2 * TAB_FLOATS + ((ui - 1) & 1) * SSX_FLOATS, tid);
        E(acc, cur, wr, wc, fr, fq, TAB + (ui & 1) * TAB_FLOATS, TAB + 2 * TAB_FLOATS + (ui & 1) * SSX_FLOATS);
        prv = cur;
        if (!has_next) break;
        if constexpr (Epi::HAS_PREF) E.pref_commit(STG, TAB + ((ui + 1) & 1) * TAB_FLOATS, tid);
#pragma unroll
        for (int a = 0; a < 2; ++a)
#pragma unroll
            for (int b = 0; b < 2; ++b)
#pragma unroll
                for (int m = 0; m < 4; ++m)
#pragma unroll
                    for (int n = 0; n < 2; ++n) acc[a][b][m][n] = (f32x4){0.f, 0.f, 0.f, 0.f};
        cur = nxt; cA = nA; cB = nB; ++ui;
        if (wr == 1) PG8_BAR;
    }
    PG8_WAIT_V(0);
    PG8_WAIT_L(0); PG8_BAR; asm volatile("" ::: "memory");
    E.post(prv, TAB + 2 * TAB_FLOATS + (ui & 1) * SSX_FLOATS, tid);
#undef PG8_SA
#undef PG8_SB
#undef PG8_STAGE
#undef PG8_LDA
#undef PG8_LDB
#undef PG8_MMA
#undef PG8_WAIT_V
#undef PG8_WAIT_L
#undef PG8_BAR
#undef PG8_SCHED
}
}

namespace att {
constexpr int D = 128, NW = 8, QBLK = 32, KVBLK = 64;
constexpr float SCALE = 0.088388347648318440f;
constexpr float THR = 8.f;
constexpr int LDQ = DM, LDK = DM;
constexpr size_t SHM_V = KVBLK * D * 2, SHM_K = KVBLK * D * 2, SHM_ATTN = 2 * SHM_V + 2 * SHM_K + NW * 64 * 4;
#define KSWZ(row, colB) ((row) * 256 + ((colB) ^ (((row) & 7) << 4)))
#define SBAR() __builtin_amdgcn_sched_barrier(0)
__device__ __forceinline__ int crow(int r, int hi) { return (r & 3) + 8 * (r >> 2) + 4 * hi; }
__device__ __forceinline__ unsigned cvtpk(float lo, float hi) { unsigned r; asm volatile("v_cvt_pk_bf16_f32 %0, %1, %2" : "=v"(r) : "v"(lo), "v"(hi)); return r; }
__device__ __forceinline__ void partialSM(f32x16& p0, f32x16& p1, float& m_reg, float& mn, float& alpha) {
  constexpr float C = SCALE * 1.4426950408889634f;
  float pmax = p0[0];
#pragma unroll
  for (int r = 1; r < 16; ++r) pmax = fmaxf(pmax, p0[r]);
#pragma unroll
  for (int r = 0; r < 16; ++r) pmax = fmaxf(pmax, p1[r]);
  { auto rr = __builtin_amdgcn_permlane32_swap(__float_as_uint(pmax), __float_as_uint(pmax), false, false);
    pmax = fmaxf(__uint_as_float(rr[0]), __uint_as_float(rr[1])); }
  if (__builtin_expect(__all(pmax - m_reg <= THR / SCALE), 1)) { mn = m_reg; alpha = 1.f; }
  else { mn = fmaxf(m_reg, pmax); alpha = __builtin_amdgcn_exp2f((m_reg - mn) * C); m_reg = mn; }
  float mnC = -mn * C;
#pragma unroll
  for (int r = 0; r < 16; ++r) p0[r] = fmaf(p0[r], C, mnC);
#pragma unroll
  for (int r = 0; r < 16; ++r) p1[r] = fmaf(p1[r], C, mnC);
#pragma unroll
  for (int r = 0; r < 16; ++r) p0[r] = __builtin_amdgcn_exp2f(p0[r]);
}
__device__ __forceinline__ void finishSM(f32x16& p0, f32x16& p1, float alpha, float& l_reg, bf16x8& pa0, bf16x8& pa1, bf16x8& pa2, bf16x8& pa3) {
#pragma unroll
  for (int r = 0; r < 16; ++r) p1[r] = __builtin_amdgcn_exp2f(p1[r]);
  float ps = 0;
#pragma unroll
  for (int r = 0; r < 16; ++r) ps += p0[r];
#pragma unroll
  for (int r = 0; r < 16; ++r) ps += p1[r];
  { auto rr = __builtin_amdgcn_permlane32_swap(__float_as_uint(ps), __float_as_uint(ps), false, false);
    ps = __uint_as_float(rr[0]) + __uint_as_float(rr[1]); }
  l_reg = l_reg * alpha + ps;
#define PK4(P, BASE, OUT) do { unsigned a0 = cvtpk(P[BASE + 0], P[BASE + 1]), a1 = cvtpk(P[BASE + 2], P[BASE + 3]);   \
    unsigned b0 = cvtpk(P[BASE + 4], P[BASE + 5]), b1 = cvtpk(P[BASE + 6], P[BASE + 7]);                              \
    auto r0 = __builtin_amdgcn_permlane32_swap(a0, b0, false, false); auto r1 = __builtin_amdgcn_permlane32_swap(a1, b1, false, false); \
    u32x4 w = {r0[0], r1[0], r0[1], r1[1]}; OUT = *reinterpret_cast<bf16x8*>(&w); } while (0)
  PK4(p0, 0, pa0); PK4(p0, 8, pa1); PK4(p1, 0, pa2); PK4(p1, 8, pa3);
#undef PK4
}
__device__ __forceinline__ void qkt(f32x16& p0, f32x16& p1, const bf16_t* Ks, const bf16x8* qr, int r32, int hi) {
  p0 = f32x16{}; p1 = f32x16{};
#pragma unroll
  for (int d0 = 0; d0 < 8; ++d0) { int cb = (d0 * 16 + hi * 8) * 2;
    bf16x8 b0 = *reinterpret_cast<const bf16x8*>((const char*)Ks + KSWZ(r32, cb));
    bf16x8 b1 = *reinterpret_cast<const bf16x8*>((const char*)Ks + KSWZ(32 + r32, cb));
    p0 = __builtin_amdgcn_mfma_f32_32x32x16_bf16(b0, qr[d0], p0, 0, 0, 0);
    p1 = __builtin_amdgcn_mfma_f32_32x32x16_bf16(b1, qr[d0], p1, 0, 0, 0); }
}
__device__ __forceinline__ int v_st(int k, int c) { const int kk = (k & ~0xC) | ((k & 4) << 1) | ((k & 8) >> 1); return ((kk >> 3) * 4 + (c >> 5)) * 512 + ((kk & 7) * 32 + (c & 31)) * 2; }
__device__ __forceinline__ int v_rd_base(int lane) { return ((lane & 3) << 3) | (((lane >> 2) & 3) << 6) | (((lane >> 4) & 1) << 5) | (((lane >> 5) & 1) << 8); }
constexpr int v_rd_off(int d0, int ks, int half) { return d0 * 512 + ks * 4096 + half * 2048; }
template <int OFF> __device__ __forceinline__ s16x4 tr_read(int vb) {
  s16x4 r; asm volatile("ds_read_b64_tr_b16 %0, %1 offset:%2" : "=&v"(r) : "v"(vb), "i"(OFF) : "memory"); return r;
}
template <int D0> __device__ __forceinline__ void pv_one(f32x16& od, int vb, bf16x8 pa0, bf16x8 pa1, bf16x8 pa2, bf16x8 pa3) {
  const s16x4 l0 = tr_read<v_rd_off(D0, 0, 0)>(vb), h0 = tr_read<v_rd_off(D0, 0, 1)>(vb), l1 = tr_read<v_rd_off(D0, 1, 0)>(vb), h1 = tr_read<v_rd_off(D0, 1, 1)>(vb);
  const s16x4 l2 = tr_read<v_rd_off(D0, 2, 0)>(vb), h2 = tr_read<v_rd_off(D0, 2, 1)>(vb), l3 = tr_read<v_rd_off(D0, 3, 0)>(vb), h3 = tr_read<v_rd_off(D0, 3, 1)>(vb);
  asm volatile("s_waitcnt lgkmcnt(0)" ::: "memory"); SBAR();
#define PK(L, H) (bf16x8){L[0], L[1], L[2], L[3], H[0], H[1], H[2], H[3]}
  od = __builtin_amdgcn_mfma_f32_32x32x16_bf16(pa0, PK(l0, h0), od, 0, 0, 0);
  od = __builtin_amdgcn_mfma_f32_32x32x16_bf16(pa1, PK(l1, h1), od, 0, 0, 0);
  od = __builtin_amdgcn_mfma_f32_32x32x16_bf16(pa2, PK(l2, h2), od, 0, 0, 0);
  od = __builtin_amdgcn_mfma_f32_32x32x16_bf16(pa3, PK(l3, h3), od, 0, 0, 0);
#undef PK
}
__device__ __forceinline__ void pv_d0(f32x16* o, int vb, bf16x8 pa0, bf16x8 pa1, bf16x8 pa2, bf16x8 pa3) {
  pv_one<0>(o[0], vb, pa0, pa1, pa2, pa3); pv_one<1>(o[1], vb, pa0, pa1, pa2, pa3); pv_one<2>(o[2], vb, pa0, pa1, pa2, pa3); pv_one<3>(o[3], vb, pa0, pa1, pa2, pa3);
}

__device__ __forceinline__ void attn_pass(const bf16_t* __restrict__ Qb, const bf16_t* __restrict__ Kh, const bf16_t* __restrict__ Vh, int seq, char* lds, f32x16 (&o)[4]) {
  const int tid = opaque_tid(), wid = tid >> 6, lane = tid & 63, r32 = lane & 31, hi = lane >> 5;
  bf16_t* V_lds = (bf16_t*)lds; bf16_t* K_lds = (bf16_t*)(lds + 2 * SHM_V);
  float* ws = (float*)(lds + 2 * SHM_V + 2 * SHM_K) + wid * 64; float* li_l = ws; float* al_l = ws + 32;
  float m_reg = -1e30f, l_reg = 0; bf16x8 qr[8];
#pragma unroll
  for (int d = 0; d < 4; ++d) o[d] = f32x16{};
  const bf16_t* Qw = Qb + (long)(wid * QBLK + r32) * LDQ + hi * 8;
#pragma unroll
  for (int d0 = 0; d0 < 8; ++d0) qr[d0] = *reinterpret_cast<const bf16x8*>(Qw + d0 * 16);
  const int sr = tid >> 4, sc = (tid & 15) * 8, vst0 = v_st(sr, sc), vst1 = v_st(32 + sr, sc);
  const int vb0 = (int)(uintptr_t)V_lds + v_rd_base(lane);
  struct { bf16x8 vs0, vs1, ks0, ks1; } sr_[1];
#define SLOAD(i, k0) do { sr_[i].vs0 = *reinterpret_cast<const bf16x8*>(&Vh[(long)((k0) + sr) * LDK + sc]); sr_[i].vs1 = *reinterpret_cast<const bf16x8*>(&Vh[(long)((k0) + 32 + sr) * LDK + sc]); \
    sr_[i].ks0 = *reinterpret_cast<const bf16x8*>(&Kh[(long)((k0) + sr) * LDK + sc]); sr_[i].ks1 = *reinterpret_cast<const bf16x8*>(&Kh[(long)((k0) + 32 + sr) * LDK + sc]); } while (0)
#define SWRITE(b, i) do { *(bf16x8*)((char*)V_lds + (b) * SHM_V + vst0) = sr_[i].vs0;          \
    *(bf16x8*)((char*)V_lds + (b) * SHM_V + vst1) = sr_[i].vs1; int kc = sc * 2;               \
    *(bf16x8*)((char*)K_lds + (b) * SHM_K + KSWZ(sr, kc)) = sr_[i].ks0;                       \
    *(bf16x8*)((char*)K_lds + (b) * SHM_K + KSWZ(32 + sr, kc)) = sr_[i].ks1; } while (0)
#define SWAIT() asm volatile("s_waitcnt vmcnt(0)" ::: "memory")
#define RESC(a) do { if (__any((a) < 1.f)) { if (hi == 0) al_l[r32] = (a); asm volatile("s_waitcnt lgkmcnt(0)" ::: "memory"); \
    _Pragma("unroll") for (int d = 0; d < 4; ++d) _Pragma("unroll") for (int r = 0; r < 16; ++r) o[d][r] *= al_l[crow(r, hi)]; } } while (0)
  f32x16 pA0, pA1, pB0, pB1; float mnA, mnB, alA, alB; bf16x8 pa0, pa1, pa2, pa3; const int NT = seq / KVBLK;
  constexpr int SE = 0, SO = 0;
  SLOAD(SE, 0); asm volatile("s_waitcnt vmcnt(0)" ::: "memory"); SWRITE(0, SE); __syncthreads();
  qkt(pA0, pA1, K_lds, qr, r32, hi); partialSM(pA0, pA1, m_reg, mnA, alA);
  SLOAD(SO, KVBLK);
  SWAIT(); SWRITE(1, SO); __syncthreads();
  for (int j = 1; j + 1 < NT; j += 2) {
    SBAR(); qkt(pB0, pB1, (bf16_t*)((char*)K_lds + SHM_K), qr, r32, hi);
    finishSM(pA0, pA1, alA, l_reg, pa0, pa1, pa2, pa3); SBAR();
    SLOAD(SO, (j + 1) * KVBLK); SBAR();
    pv_d0(o, vb0, pa0, pa1, pa2, pa3); partialSM(pB0, pB1, m_reg, mnB, alB);
    __syncthreads(); SWAIT(); SWRITE(0, SE);
    RESC(alB); __syncthreads();
    SBAR(); qkt(pA0, pA1, K_lds, qr, r32, hi);
    finishSM(pB0, pB1, alB, l_reg, pa0, pa1, pa2, pa3); SBAR();
    SLOAD(SE, (j + 2) * KVBLK); SBAR();
    pv_d0(o, vb0 + (int)SHM_V, pa0, pa1, pa2, pa3); partialSM(pA0, pA1, m_reg, mnA, alA);
    __syncthreads(); SWAIT(); SWRITE(1, SO);
    RESC(alA); __syncthreads();
  }
  SBAR(); qkt(pB0, pB1, (bf16_t*)((char*)K_lds + SHM_K), qr, r32, hi);
  finishSM(pA0, pA1, alA, l_reg, pa0, pa1, pa2, pa3); SBAR();
  pv_d0(o, vb0, pa0, pa1, pa2, pa3); partialSM(pB0, pB1, m_reg, mnB, alB);
  __syncthreads(); RESC(alB);
  finishSM(pB0, pB1, alB, l_reg, pa0, pa1, pa2, pa3); SBAR();
  pv_d0(o, vb0 + (int)SHM_V, pa0, pa1, pa2, pa3);
  if (hi == 0) li_l[r32] = l_reg; asm volatile("s_waitcnt lgkmcnt(0)" ::: "memory");
#pragma unroll
  for (int r = 0; r < 16; ++r) { const float rl = __builtin_amdgcn_rcpf(li_l[crow(r, hi)]);
#pragma unroll
    for (int d0 = 0; d0 < 4; ++d0) o[d0][r] *= rl; }
  __syncthreads();
#undef SLOAD
#undef SWRITE
#undef SWAIT
#undef RESC
}

#define ABAR() do { asm volatile("" ::: "memory"); __builtin_amdgcn_s_barrier(); asm volatile("" ::: "memory"); __builtin_amdgcn_sched_barrier(0); } while (0)
__device__ __forceinline__ void qkt_l(f32x16& p0, f32x16& p1, const LAS char* Ks, const bf16x8* qr, int r32, int hi) {
  p0 = f32x16{}; p1 = f32x16{};
#pragma unroll
  for (int d0 = 0; d0 < 8; ++d0) { const int cb = (d0 * 16 + hi * 8) * 2;
    const bf16x8 b0 = *(const LAS bf16x8*)(Ks + KSWZ(r32, cb));
    const bf16x8 b1 = *(const LAS bf16x8*)(Ks + KSWZ(32 + r32, cb));
    p0 = __builtin_amdgcn_mfma_f32_32x32x16_bf16(b0, qr[d0], p0, 0, 0, 0);
    p1 = __builtin_amdgcn_mfma_f32_32x32x16_bf16(b1, qr[d0], p1, 0, 0, 0);
    if ((d0 & 3) == 3) SBAR(); }
}
__device__ __forceinline__ void attn_pass2(const bf16_t* __restrict__ Qb, const bf16_t* __restrict__ Kh, const bf16_t* __restrict__ Vh, int seq, LAS unsigned char* lds, f32x16 (&o)[8]) {
  const int tid = opaque_tid(), wid = __builtin_amdgcn_readfirstlane(tid >> 6), lane = tid & 63, r32 = lane & 31, hi = lane >> 5;
  constexpr int KB0 = 0, VB0 = 32768, WS0 = 98304;
  LAS float* li_l = (LAS float*)(lds + WS0) + wid * 64; LAS float* al_l = li_l + 32;
  unsigned kof, vof;
  { const int q = wid * 64 + lane, row = q >> 4, cs = q & 15; kof = (unsigned)(row * LDK + ((cs ^ (row & 7)) << 3)) * 2u; }
  { const int B = (wid * 64 + lane) * 16, sub = B >> 9, within = B & 511;
    const int kk = (sub >> 2) * 8 + (within >> 6), k = (kk & ~0xC) | ((kk & 4) << 1) | ((kk & 8) >> 1), c = (sub & 3) * 32 + ((within & 63) >> 1);
    vof = (unsigned)(k * LDK + c) * 2u; }
#define DMA_TILE(buf, k0) do { const char* kb_ = (const char*)Kh + (size_t)(k0) * LDK * 2; const char* vb_ = (const char*)Vh + (size_t)(k0) * LDK * 2; \
    _Pragma("unroll") for (int i_ = 0; i_ < 2; ++i_) __builtin_amdgcn_global_load_lds((const unsigned*)(kb_ + (size_t)i_ * 32 * LDK * 2 + kof), (LAS unsigned*)(lds + KB0 + (buf) * 16384 + (wid + 8 * i_) * 1024), 16, 0, 0); \
    _Pragma("unroll") for (int i_ = 0; i_ < 4; ++i_) __builtin_amdgcn_global_load_lds((const unsigned*)(vb_ + (size_t)(i_ & 1) * 32 * LDK * 2 + (size_t)(i_ >> 1) * 256 + vof), (LAS unsigned*)(lds + VB0 + (buf) * 32768 + (wid + 8 * i_) * 1024), 16, 0, 0); } while (0)
#define RESC2(a) do { if (__any((a) < 1.f)) { if (hi == 0) al_l[r32] = (a); asm volatile("s_waitcnt lgkmcnt(0)" ::: "memory"); \
    _Pragma("unroll") for (int d = 0; d < 8; ++d) _Pragma("unroll") for (int r = 0; r < 16; ++r) o[d][r] *= al_l[crow(r, hi)]; } } while (0)
  float m_reg = -1e30f, l_reg = 0.f; bf16x8 qr[8];
#pragma unroll
  for (int d = 0; d < 8; ++d) o[d] = f32x16{};
  const bf16_t* Qw = Qb + (long)(wid * QBLK + r32) * LDQ + hi * 8;
#pragma unroll
  for (int d0 = 0; d0 < 8; ++d0) qr[d0] = *reinterpret_cast<const bf16x8*>(Qw + d0 * 16);
  const int vb0 = (int)(unsigned)(uintptr_t)(lds + VB0) + v_rd_base(lane);
  const int NT = seq / KVBLK;
  DMA_TILE(0, 0); DMA_TILE(1, KVBLK);
#define TILE(buf, j) do { \
    if ((j) + 1 < NT) asm volatile("s_waitcnt vmcnt(6)" ::: "memory"); else asm volatile("s_waitcnt vmcnt(0)" ::: "memory"); \
    ABAR(); \
    f32x16 p0, p1; float mn, alpha; bf16x8 pa0, pa1, pa2, pa3; \
    qkt_l(p0, p1, (const LAS char*)(lds + KB0 + (buf) * 16384), qr, r32, hi); \
    partialSM(p0, p1, m_reg, mn, alpha); \
    RESC2(alpha); \
    finishSM(p0, p1, alpha, l_reg, pa0, pa1, pa2, pa3); SBAR(); \
    pv_d0(o, vb0 + (buf) * 32768, pa0, pa1, pa2, pa3); pv_d0(o + 4, vb0 + (buf) * 32768 + 16384, pa0, pa1, pa2, pa3); \
    ABAR(); \
    if ((j) + 2 < NT) DMA_TILE(buf, ((j) + 2) * KVBLK); } while (0)
  for (int j = 0; j < NT; j += 2) { TILE(0, j); TILE(1, j + 1); }
  if (hi == 0) li_l[r32] = l_reg; asm volatile("s_waitcnt lgkmcnt(0)" ::: "memory");
#pragma unroll
  for (int r = 0; r < 16; ++r) { const float rl = __builtin_amdgcn_rcpf(li_l[crow(r, hi)]);
#pragma unroll
    for (int d = 0; d < 8; ++d) o[d][r] *= rl; }
#undef DMA_TILE
#undef RESC2
#undef TILE
}
}

#define XB_TMO      128
#define XB_XCNT(j)  (256  + 64 * (j))
#define XB_XSUB(j)  (1280 + 64 * (j))
#define XB_XGEN(j)  (2304 + 64 * (j))
#define XB_TOP      3328
#define XB_TOPGEN   3392
#define XCD_BAR_WORDS 3456
#define XB_SPIN_CAP (1u << 18)
__device__ __forceinline__ unsigned xb_ld(unsigned* p)              { return __hip_atomic_load(p, __ATOMIC_RELAXED, __HIP_MEMORY_SCOPE_AGENT); }
__device__ __forceinline__ unsigned xb_add(unsigned* p, unsigned v) { return __hip_atomic_fetch_add(p, v, __ATOMIC_RELAXED, __HIP_MEMORY_SCOPE_AGENT); }
__device__ __forceinline__ unsigned xb_xcc_id() { return (unsigned)__builtin_amdgcn_s_getreg((3 << 11) | 20) & 0xFu; }
#define XB_SPIN(cond, bar) do { unsigned _sp = 0; while (cond) { __builtin_amdgcn_s_sleep(1); \
    if ((++_sp & 255u) == 0u) { if (xb_ld(&(bar)[XB_TMO])) break; if (_sp > XB_SPIN_CAP) { atomicAdd(&(bar)[XB_TMO], 1u); break; } } } } while (0)
struct XcdBarrier { unsigned* bar; unsigned x; volatile LAS unsigned* st; };
__device__ __forceinline__ XcdBarrier xcd_barrier_post(unsigned* bar, volatile LAS unsigned* st) {
    XcdBarrier b; b.bar = bar; b.x = xb_xcc_id(); b.st = st;
    if (threadIdx.x == 0) (void)xb_add(&bar[XB_XCNT(b.x)], 1u);
    return b;
}
__device__ __forceinline__ void xcd_barrier_complete(unsigned* bar, unsigned x, unsigned& nloc, unsigned& nx) {
    const unsigned G = gridDim.x * gridDim.y * gridDim.z;
    unsigned sum, cnt, mine, sp = 0u;
    for (;;) {
        sum = 0u; cnt = 0u; mine = 0u;
#pragma unroll
        for (unsigned j = 0; j < 16; ++j) { const unsigned c = xb_ld(&bar[XB_XCNT(j)]); sum += c; cnt += (c > 0u) ? 1u : 0u; mine = (j == x) ? c : mine; }
        if (sum == G) break;
        __builtin_amdgcn_s_sleep(1);
        if ((++sp & 255u) == 0u) { if (xb_ld(&bar[XB_TMO])) break; if (sp > XB_SPIN_CAP) { atomicAdd(&bar[XB_TMO], 1u); break; } }
    }
    nloc = mine > 0u ? mine : 1u; nx = cnt > 0u ? cnt : 1u;
}
__device__ __forceinline__ void xcd_barrier(const XcdBarrier& b) {
    asm volatile("s_waitcnt vmcnt(0)" ::: "memory");
    __syncthreads();
    if (threadIdx.x == 0) {
        unsigned* bar = b.bar;
        __builtin_amdgcn_s_waitcnt(0);
        unsigned nloc = b.st[0], nx = b.st[1];
        if (nloc == 0u) { xcd_barrier_complete(bar, b.x, nloc, nx); b.st[0] = nloc; b.st[1] = nx; }
        const unsigned old = xb_add(&bar[XB_XSUB(b.x)], 1u);
        const unsigned gen = old / nloc;
        if (old + 1u == (gen + 1u) * nloc) {
            __builtin_amdgcn_fence(__ATOMIC_RELEASE, "agent");
            asm volatile("s_waitcnt vmcnt(0)" ::: "memory");
            const unsigned og = xb_add(&bar[XB_TOP], 1u);
            const unsigned tg = og / nx;
            if (og + 1u == (tg + 1u) * nx) xb_add(&bar[XB_TOPGEN], 1u);
            else XB_SPIN(xb_ld(&bar[XB_TOPGEN]) == tg, bar);
            __builtin_amdgcn_fence(__ATOMIC_ACQUIRE, "agent");
            xb_add(&bar[XB_XGEN(b.x)], 1u);
            asm volatile("s_waitcnt vmcnt(0)" ::: "memory");
        } else {
            XB_SPIN(xb_ld(&bar[XB_XGEN(b.x)]) == gen, bar);
            __builtin_amdgcn_fence(__ATOMIC_ACQUIRE, "agent");
            asm volatile("s_waitcnt vmcnt(0)" ::: "memory");
        }
    }
    __syncthreads();
}

template <int MODE>
__device__ __forceinline__ void rowop_phase(int G, int bx, const float* x0, const float* x1, const float* g, const float* shiftp, const float* scalep,
                                            float* rstd_out, bf16_t* hout, float* fout) {
    const int tid = opaque_tid(), wave = __builtin_amdgcn_readfirstlane(tid >> 6), lane = tid & 63;
    const int NWV = G * 8, gw = bx * 8 + wave, rpw = (MROWS + NWV - 1) / NWV;
    const int r0 = gw * rpw, r1 = (r0 + rpw < MROWS) ? r0 + rpw : MROWS;
    f32x4 gp[8], sh[8]; int cur_ci = -1;
    if (MODE == 2) {
#pragma unroll
        for (int j = 0; j < 8; ++j) gp[j] = ((const f32x4*)g)[lane + 64 * j];
    }
    for (int row = r0; row < r1; ++row) {
        const float* xr = row < NCTX ? x0 + (size_t)row * DM : x1 + (size_t)(row - NCTX) * DM;
        f32x4 v[8]; float s = 0.f;
        if (MODE == 2) {
            const u32x2* xr16 = (const u32x2*)((const bf16_t*)x0 + (size_t)row * DM) + lane; const u32x2* dr = (const u32x2*)(hout + (size_t)row * DM) + lane;
#pragma unroll
            for (int j = 0; j < 8; ++j) { v[j] = h4_to_f4(xr16[64 * j]) + bf4_to_f4(dr[64 * j]); s += dot4(v[j]); }
        } else {
#pragma unroll
        for (int j = 0; j < 8; ++j) { v[j] = ((const f32x4*)xr)[lane + 64 * j]; s += dot4(v[j]); }
        }
        s = wave_sum(s);
        const float rs = 1.0f / sqrtf(s * (1.0f / DM) + EPS);
        if (MODE == 0) { if (lane == 0) rstd_out[row] = rs; continue; }
        if (MODE == 1) {
            const int ci = row < NCTX ? 8 : ((row - NCTX) >> 12);
            if (ci != cur_ci) { cur_ci = ci;
#pragma unroll
                for (int j = 0; j < 8; ++j) { const f32x4 gg = ((const f32x4*)g)[lane + 64 * j], scv = ((const f32x4*)(scalep + (size_t)ci * NMOD))[lane + 64 * j];
                    gp[j] = gg * (scv + 1.0f); sh[j] = ((const f32x4*)(shiftp + (size_t)ci * NMOD))[lane + 64 * j]; } }
            u32x2* o8 = (u32x2*)(hout + (size_t)row * DM) + lane;
#pragma unroll
            for (int j = 0; j < 8; ++j) { const f32x4 h = v[j] * rs * gp[j] + sh[j]; u32x2 w; w.x = cvt_pk_bf16(h.x, h.y); w.y = cvt_pk_bf16(h.z, h.w); o8[64 * j] = w; }
        }
        if (MODE == 2) { f32x4* o = (f32x4*)(fout + (size_t)row * DM) + lane;
#pragma unroll
            for (int j = 0; j < 8; ++j) o[64 * j] = v[j] * rs * gp[j]; }
    }
}

template <bool F16> struct PoolStage;
template <> struct PoolStage<true>  { typedef u32x2 T; static __device__ __forceinline__ f32x4 cvt(u32x2 r) { return h4_to_f4(r); } };
template <> struct PoolStage<false> { typedef f32x4 T; static __device__ __forceinline__ f32x4 cvt(f32x4 r) { return r; } };
template <int W>
__device__ __forceinline__ void pool_compute(const LAS f32x4* T, const LAS float* RL, int cq, int tl0, int t0, int s0, int s1, f32x4 gp, bf16_t* dcol) {
    constexpr int HW = W / 2, NR = W + 7;
    f32x4 r[NR];
    int rb = tl0 + 8 - HW; asm volatile("" : "+v"(rb));
    const LAS f32x4* Tb = T + rb * 64 + cq; const LAS float* Rb = RL + rb;
#pragma unroll
    for (int i = 0; i < NR; ++i) r[i] = Tb[i * 64] * Rb[i];
#pragma unroll
    for (int k = 0; k < 8; ++k) { const int t = t0 + tl0 + k; const int lo = (t - HW > s0) ? t - HW : s0, hi = (t - HW + W < s1) ? t - HW + W : s1;
        f32x4 sum = r[k];
#pragma unroll
        for (int i = 1; i < W; ++i) sum = sum + r[k + i];
        const f32x4 d = gp * (sum * (1.0f / (float)(hi - lo)) - r[k + HW]);
        u32x2 o; o.x = cvt_pk_bf16(d.x, d.y); o.y = cvt_pk_bf16(d.z, d.w);
        *(u32x2*)(dcol + (size_t)t * DM) = o; }
}
template <bool F16>
__device__ __forceinline__ void pool_phase(LAS unsigned char* lds, int G, int bx, const float* x0, const float* x1, const bf16_t* x16, const float* rstd, const float* ssq, const float* g, const float* scalep, bf16_t* dout) {
    LAS f32x4* T = (LAS f32x4*)lds;
    LAS float* RL = (LAS float*)(lds + 80 * 64 * 16);
    int tid = opaque_tid(), cq = tid & 63, ts = tid >> 6;
    constexpr int NU = (MROWS / 64) * 8;
    typedef typename PoolStage<F16>::T PT;
    PT preA[10], preB[F16 ? 10 : 1]; f32x4 prA, prB; unsigned pvA = 0u, pvB = 0u;
#define POOL_GEOM(u) const int tt = (u) >> 3, cb = (u) & 7, t0 = tt * 64, c0 = cb * 256 + 4 * cq; \
        int s0, s1, ci, radj; const float* xb; \
        if (t0 < NCTX) { s0 = t0 & ~(CTXSEQ - 1); s1 = s0 + CTXSEQ; xb = x0; radj = 0; ci = 8; } \
        else { s0 = NCTX + ((t0 - NCTX) & ~(LATSEQ - 1)); s1 = s0 + LATSEQ; xb = x1; radj = NCTX; ci = (t0 - NCTX) >> 12; }
#define POOL_LOAD(u, PRE, PR, PV) do { POOL_GEOM(u); (void)ci; PV = 0u; \
        _Pragma("unroll") for (int i = 0; i < 10; ++i) { const int j = ts + 8 * i, t = t0 - 8 + j; const int tc = t < s0 ? s0 : (t >= s1 ? s1 - 1 : t); \
            if constexpr (F16) PRE[i] = *(const PT*)(x16 + (size_t)tc * DM + c0); else PRE[i] = *(const PT*)(xb + (size_t)(tc - radj) * DM + c0); \
            PV |= ((j < 79 && t >= s0 && t < s1) ? 1u : 0u) << i; } \
        { const int j = tid >> 1, t = t0 - 8 + j; const int tc = t < s0 ? s0 : (t >= s1 ? s1 - 1 : t); \
          if (ssq) PR = *(const f32x4*)(ssq + (size_t)tc * 8 + (tid & 1) * 4); else { PR = (f32x4){0.f, 0.f, 0.f, 0.f}; PR.x = rstd[tc]; } \
          if (!(j < 79 && t >= s0 && t < s1)) PR = (f32x4){0.f, 0.f, 0.f, 0.f}; } } while (0)
#define POOL_UNIT(uu, PRE, PR, PV, UNEXT) do { \
        asm volatile("" : "+v"(tid)); cq = tid & 63; ts = tid >> 6; \
        _Pragma("unroll") for (int i = 0; i < 10; ++i) { const int j = ts + 8 * i; const f32x4 v = PoolStage<F16>::cvt(PRE[i]); \
            if (j < 80) T[j * 64 + cq] = ((PV >> i) & 1u) ? v : (f32x4){0.f, 0.f, 0.f, 0.f}; } \
        { float sq = (PR.x + PR.y) + (PR.z + PR.w); float rv; \
          if (ssq) { sq = add_xor1(sq); rv = 1.0f / sqrtf(sq * (1.0f / DM) + EPS); } else rv = PR.x; \
          if ((tid & 1) == 0 && (tid >> 1) < 80) RL[tid >> 1] = rv; } \
        __syncthreads(); \
        if ((UNEXT) < NU) POOL_LOAD(UNEXT, PRE, PR, PV); \
        { POOL_GEOM(uu); (void)xb; (void)radj; \
          const f32x4 gp = *(const f32x4*)(g + c0) * (*(const f32x4*)(scalep + (size_t)ci * NMOD + c0) + 1.0f); \
          const int wsel = cb >> 1; \
          if (wsel == 0) pool_compute<2>(T, RL, cq, ts * 8, t0, s0, s1, gp, dout + c0); \
          else if (wsel == 1) pool_compute<4>(T, RL, cq, ts * 8, t0, s0, s1, gp, dout + c0); \
          else if (wsel == 2) pool_compute<8>(T, RL, cq, ts * 8, t0, s0, s1, gp, dout + c0); \
          else pool_compute<16>(T, RL, cq, ts * 8, t0, s0, s1, gp, dout + c0); } \
        __syncthreads(); } while (0)
    int u = bx;
    if (u < NU) POOL_LOAD(u, preA, prA, pvA);
    if constexpr (F16) {
        if (u + G < NU) POOL_LOAD(u + G, preB, prB, pvB);
        for (; u < NU; u += 2 * G) {
            POOL_UNIT(u, preA, prA, pvA, u + 2 * G);
            if (u + G < NU) POOL_UNIT(u + G, preB, prB, pvB, u + 3 * G);
        }
    } else {
        for (; u < NU; u += G) POOL_UNIT(u, preA, prA, pvA, u + G);
        (void)preB; (void)prB; (void)pvB;
    }
#undef POOL_GEOM
#undef POOL_LOAD
#undef POOL_UNIT
}

__device__ __forceinline__ void sw_compute(LAS unsigned char* lds, int G, int bx, const bf16_t* Wt, int N, const float* shiftp  , float* out  ) {
    LAS float* ST = (LAS float*)lds;
    const int tid = opaque_tid(), wave = tid >> 6, lane = tid & 63;
    __syncthreads();
    { f32x4 sv[9];
#pragma unroll
      for (int k = 0; k < 9; ++k) sv[k] = *(const f32x4*)(shiftp + (size_t)k * NMOD + tid * 4);
#pragma unroll
      for (int k = 0; k < 9; ++k) *(LAS f32x4*)(ST + k * DM + tid * 4) = sv[k]; }
    __syncthreads();
    const int gw = bx * 8 + wave, NGW = G * 8;
    u32x2 wv[8], wn[8], wm[8];
    int n = gw;
    if (n < N) {
#pragma unroll
        for (int j = 0; j < 8; ++j) wn[j] = *(const u32x2*)(Wt + (size_t)n * DM + j * 256 + lane * 4); }
    if (n + NGW < N) {
#pragma unroll
        for (int j = 0; j < 8; ++j) wm[j] = *(const u32x2*)(Wt + (size_t)(n + NGW) * DM + j * 256 + lane * 4); }
    for (; n < N; n += NGW) {
#pragma unroll
        for (int j = 0; j < 8; ++j) { wv[j] = wn[j]; wn[j] = wm[j]; }
        if (n + 2 * NGW < N) {
#pragma unroll
            for (int j = 0; j < 8; ++j) wm[j] = *(const u32x2*)(Wt + (size_t)(n + 2 * NGW) * DM + j * 256 + lane * 4); }
        f32x4 wf[8];
#pragma unroll
        for (int j = 0; j < 8; ++j) wf[j] = (f32x4){__uint_as_float(wv[j].x << 16), __uint_as_float(wv[j].x & 0xffff0000u), __uint_as_float(wv[j].y << 16), __uint_as_float(wv[j].y & 0xffff0000u)};
#pragma unroll 1
        for (int ci = 0; ci < 9; ++ci) { f32x4 a = (f32x4){0.f, 0.f, 0.f, 0.f};
#pragma unroll
            for (int j = 0; j < 8; ++j) a = a + *(const LAS f32x4*)(ST + ci * DM + j * 256 + lane * 4) * wf[j];
            const float r = wave_sum((a.x + a.y) + (a.z + a.w));
            if (lane == 0) out[(size_t)ci * N + n] = r; }
    }
}

__device__ __forceinline__ void sgu_phase(LAS unsigned char* lds, int G, int bx, const bf16_t* Z, const float* vss, const float* ng, const bf16_t* Wbf, const float* bs, bf16_t* Sout) {
    const int tid = opaque_tid(), wave = tid >> 6, lane = tid & 63, r32 = lane & 31, hi = lane >> 5;
    LAS float* RS = (LAS float*)(lds + 131072);
    LAS float* EB = (LAS float*)(lds + 65536 + wave * 8192);
    const int sr = tid >> 4, sc = (tid & 15) * 8;
    const int pb = wave & 3, ct = wave >> 2;
    const int eg = lane & 7, rsub = lane >> 3;
    constexpr int NU = (MROWS / 128) * 8;
    bf16x8 raw[8]; f32x4 part[2];
#define SGU_PREFETCH(u) do { const int chunk_ = (u) >> 3, g_ = (u) & 7, row0_ = chunk_ * 128; \
        _Pragma("unroll") for (int kt = 0; kt < 2; ++kt) _Pragma("unroll") for (int c2 = 0; c2 < 2; ++c2) _Pragma("unroll") for (int hf = 0; hf < 2; ++hf) \
            raw[(kt * 2 + c2) * 2 + hf] = *(const bf16x8*)(Z + (size_t)(row0_ + kt * 64 + hf * 32 + sr) * 4096 + 2048 + g_ * 256 + c2 * 128 + sc); \
        { const f32x4* p_ = (const f32x4*)(vss + (size_t)(row0_ + (tid >> 2)) * 32 + (tid & 3) * 8); part[0] = p_[0]; part[1] = p_[1]; } } while (0)
    int u = bx;
    if (u < NU) SGU_PREFETCH(u);
    for (; u < NU; u += G) {
        const int chunk = u >> 3, g = u & 7, row0 = chunk * 128;
        { const f32x4 a = part[0] + part[1]; float sq = (a.x + a.y) + (a.z + a.w); sq = add_xor1(sq); sq = add_xor2(sq);
          if ((tid & 3) == 0) RS[tid >> 2] = 1.0f / sqrtf(sq * (1.0f / DM) + EPS); }
        __syncthreads();
#pragma unroll
        for (int kt = 0; kt < 2; ++kt)
#pragma unroll
            for (int c2 = 0; c2 < 2; ++c2)
#pragma unroll
                for (int hf = 0; hf < 2; ++hf) { const int q = kt * 64 + hf * 32 + sr, col = c2 * 128 + sc; const bf16x8 rw = raw[(kt * 2 + c2) * 2 + hf];
                    const float rs = RS[q]; const f32x4 n0 = *(const f32x4*)(ng + g * 256 + col) * rs, n1 = *(const f32x4*)(ng + g * 256 + col + 4) * rs;
                    u32x4 w; w.x = cvt_pk_bf16(bf2f((bf16_t)rw[0]) * n0.x, bf2f((bf16_t)rw[1]) * n0.y); w.y = cvt_pk_bf16(bf2f((bf16_t)rw[2]) * n0.z, bf2f((bf16_t)rw[3]) * n0.w);
                    w.z = cvt_pk_bf16(bf2f((bf16_t)rw[4]) * n1.x, bf2f((bf16_t)rw[5]) * n1.y); w.w = cvt_pk_bf16(bf2f((bf16_t)rw[6]) * n1.z, bf2f((bf16_t)rw[7]) * n1.w);
                    *(LAS u32x4*)(lds + (kt * 2 + c2) * 16384 + att::v_st(hf * 32 + sr, sc)) = w; }
        __syncthreads();
        if (u + G < NU) SGU_PREFETCH(u + G);
        bf16x8 ucur[8];
#pragma unroll
        for (int hh = 0; hh < 2; ++hh)
#pragma unroll
            for (int i = 0; i < 4; ++i) ucur[hh * 4 + i] = *(const bf16x8*)(Z + (size_t)(row0 + pb * 32 + rsub + 8 * i) * 4096 + g * 256 + ct * 128 + hh * 64 + eg * 8);
        bf16x8 pa[8];
#pragma unroll
        for (int kk = 0; kk < 8; ++kk) pa[kk] = *(const bf16x8*)(Wbf + ((size_t)(g * 128 + pb * 32 + r32)) * 128 + kk * 16 + hi * 8);
        f32x16 o[4];
#pragma unroll
        for (int d = 0; d < 4; ++d) o[d] = f32x16{};
        const int vb = (int)(unsigned)(uintptr_t)lds + ct * 16384 + att::v_rd_base(lane);
        att::pv_d0(o, vb, pa[0], pa[1], pa[2], pa[3]);
        att::pv_d0(o, vb + 2 * 16384, pa[4], pa[5], pa[6], pa[7]);
        float bias[16];
#pragma unroll
        for (int r = 0; r < 16; ++r) bias[r] = bs[g * 128 + pb * 32 + att::crow(r, hi)];
#pragma unroll
        for (int hh = 0; hh < 2; ++hh) {
#pragma unroll
            for (int dl = 0; dl < 2; ++dl)
#pragma unroll
                for (int r = 0; r < 16; ++r) { const int rw = att::crow(r, hi), cl = dl * 32 + r32; EB[rw * 64 + (cl ^ ((rw & 7) << 3))] = o[hh * 2 + dl][r] + bias[r]; }
            asm volatile("s_waitcnt lgkmcnt(0)" ::: "memory");
#pragma unroll
            for (int i = 0; i < 4; ++i) { const int rw = rsub + 8 * i; const LAS f32x4* ep = (const LAS f32x4*)(EB + rw * 64 + ((eg ^ (rw & 7)) << 3));
                const f32x4 v0 = ep[0], v1 = ep[1]; const bf16x8 uq = ucur[hh * 4 + i];
                u32x4 w; w.x = cvt_pk_bf16(bf2f((bf16_t)uq[0]) * v0.x, bf2f((bf16_t)uq[1]) * v0.y); w.y = cvt_pk_bf16(bf2f((bf16_t)uq[2]) * v0.z, bf2f((bf16_t)uq[3]) * v0.w);
                w.z = cvt_pk_bf16(bf2f((bf16_t)uq[4]) * v1.x, bf2f((bf16_t)uq[5]) * v1.y); w.w = cvt_pk_bf16(bf2f((bf16_t)uq[6]) * v1.z, bf2f((bf16_t)uq[7]) * v1.w);
                *(u32x4*)(Sout + (size_t)(row0 + pb * 32 + rw) * DM + g * 256 + ct * 128 + hh * 64 + eg * 8) = w; }
            asm volatile("s_waitcnt lgkmcnt(0)" ::: "memory");
        }
        __syncthreads();
    }
#undef SGU_PREFETCH
}

__device__ __forceinline__ float lam_of(const float* lamp, int lane) {
    const float a = lamp[lane] * lamp[128 + lane] + lamp[64 + lane] * lamp[192 + lane], b = lamp[256 + lane] * lamp[384 + lane] + lamp[320 + lane] * lamp[448 + lane];
    return expf(wave_sum(a)) - expf(wave_sum(b)) + LAM_INIT;
}
__device__ __forceinline__ void attn_phase(LAS unsigned char* lds, int G, int vcu, const bf16_t* Qb, bf16_t* Oout, const bf16_t* Kc, const bf16_t* Vc, const bf16_t* Kall, const bf16_t* Vall,
                                           float* scratch, const float* lamp, const float* subg) {
    const int NU = 256 + 1024;
    for (int u = vcu; u < NU; u += G) {
        size_t rowbase; const bf16_t *Kb, *Vb; int seq, h;
        if (u < 256) { const int b = u >> 3; h = u & 7; rowbase = (size_t)b * CTXSEQ; Kb = Kc + rowbase * DM; Vb = Vc + rowbase * DM; seq = CTXSEQ; }
        else { const int v = u - 256, bh = v >> 4, qb = v & 15, b = bh >> 3; h = bh & 7; rowbase = (size_t)NCTX + (size_t)b * LATSEQ + (size_t)qb * 256;
            Kb = Kall + (size_t)b * KVLEN * DM; Vb = Vall + (size_t)b * KVLEN * DM; seq = KVLEN; }
        f32x16 o[8];
        att::attn_pass2(Qb + rowbase * DM + h * 256, Kb + h * 256, Vb + h * 256, seq, lds, o);
        { int tid = opaque_tid(); f32x4* Sv = (f32x4*)(scratch + ((size_t)vcu * 512 + tid) * 128);
#pragma unroll
          for (int d = 0; d < 8; ++d)
#pragma unroll
              for (int q = 0; q < 4; ++q) Sv[d * 4 + q] = (f32x4){o[d][4 * q], o[d][4 * q + 1], o[d][4 * q + 2], o[d][4 * q + 3]}; }
        att::attn_pass2(Qb + rowbase * DM + h * 256 + 128, Kb + h * 256 + 128, Vb + h * 256, seq, lds, o);
        const int tid = opaque_tid(), wid = tid >> 6, lane = tid & 63, r32 = lane & 31, hi = lane >> 5;
        const f32x4* S = (const f32x4*)(scratch + ((size_t)vcu * 512 + tid) * 128);
        const float lam = lam_of(lamp, lane);
        float ss[16];
#pragma unroll
        for (int r = 0; r < 16; ++r) ss[r] = 0.f;
#pragma unroll
        for (int d = 0; d < 8; ++d)
#pragma unroll
            for (int q = 0; q < 4; ++q) { const f32x4 t = S[d * 4 + q];
#pragma unroll
                for (int i = 0; i < 4; ++i) { const float v = t[i] - lam * o[d][4 * q + i]; o[d][4 * q + i] = v; ss[4 * q + i] += v * v; } }
        bf16_t* Ob = Oout + (rowbase + wid * 32) * DM + h * 256 + r32;
        float gg[8];
#pragma unroll
        for (int d = 0; d < 8; ++d) gg[d] = subg[d * 32 + r32] * (1.0f - LAM_INIT);
#pragma unroll
        for (int r = 0; r < 16; ++r) { float sq = ss[r];
#pragma unroll
            for (int of = 1; of < 32; of <<= 1) sq += __shfl_xor(sq, of);
            const float rs = 1.0f / sqrtf(sq * (1.0f / 256.0f) + EPS);
            bf16_t* op = Ob + (size_t)att::crow(r, hi) * DM;
#pragma unroll
            for (int d = 0; d < 8; ++d) op[d * 32] = f2bf(o[d][r] * rs * gg[d]); }
    }
}

__device__ __forceinline__ void transpose_item(const float* W, int K, int N, bf16_t* WT, int k0, int n0, int drow0, LAS float* scr, int lane) {
#pragma unroll 8
    for (int i = 0; i < 32; ++i) { const int kk = 2 * i + (lane >> 5); scr[kk * 33 + (lane & 31)] = W[(size_t)(k0 + kk) * N + n0 + (lane & 31)]; }
    asm volatile("s_waitcnt lgkmcnt(0)" ::: "memory");
    const int c = lane & 7;
#pragma unroll
    for (int j = 0; j < 4; ++j) { const int n = (lane >> 3) + 8 * j; const LAS float* s = scr + (8 * c) * 33 + n;
        u32x4 o; o.x = cvt_pk_bf16(s[0 * 33], s[1 * 33]); o.y = cvt_pk_bf16(s[2 * 33], s[3 * 33]); o.z = cvt_pk_bf16(s[4 * 33], s[5 * 33]); o.w = cvt_pk_bf16(s[6 * 33], s[7 * 33]);
        *(u32x4*)(WT + (size_t)(drow0 + n) * K + k0 + 8 * c) = o; }
    asm volatile("s_waitcnt lgkmcnt(0)" ::: "memory");
}
__device__ __forceinline__ int qkv_drow(int n0) {
    if (n0 >= 4096) return n0;
    const int sec = n0 >> 11, wi = n0 & 2047, h = wi >> 8, rem = wi & 255, mp = rem >> 7, axis = (rem >> 6) & 1, half = (rem >> 5) & 1;
    return sec * 2048 + h * 256 + half * 128 + (mp * 2 + axis) * 32;
}
__device__ __forceinline__ int ffnin_drow(int n0) { const int bj = n0 >= FFH ? 1 : 0, jj = n0 - bj * FFH; return (jj >> 7) * 256 + bj * 128 + (jj & 127); }

struct Args { const float* in[24]; float* out; unsigned char* ws; int ph_lo, ph_hi, li, pad; };

struct DArgs { GAS const float* in[24]; GAS float* out; GAS unsigned char* ws; int ph_lo, ph_hi, li, pad; };
static_assert(sizeof(DArgs) == sizeof(Args), "argument block layout");
typedef const DArgs __attribute__((address_space(4))) CArgs;
__device__ __forceinline__ void prologue(LAS unsigned char* lds, CArgs* ap, int G, int bx) {
    CArgs& a = *ap;
#define AIN(k) ((const float*)a.in[k])
    const int tid = opaque_tid(), wave = tid >> 6, lane = tid & 63;
    unsigned char* ws = (unsigned char*)a.ws;
    {
        LAS float* ST = (LAS float*)lds;
        LAS float* RED = (LAS float*)(lds + 73728);
        const float* cvec = AIN(4); const float* cctx = AIN(5); const float* ada_w = AIN(6); const float* ada_b = AIN(7);
        float* MOD = (float*)(ws + WS_MOD);
        for (int i = tid; i < 9 * DM; i += 512) { const int ci = i >> 11, k = i & 2047; const float c = ci < 8 ? cvec[ci * DM + k] : cctx[k]; ST[i] = c / (1.0f + expf(-c)); }
        __syncthreads();
        const int cq = lane & 15, ks = lane >> 4;
        for (int au = bx; au < 768; au += G) {
            const int l = au / 192, col0 = (au % 192) * 64;
            const float* wp = ada_w + ((size_t)l * DM + wave * 256 + ks) * NMOD + col0 + 4 * cq;
            f32x4 acc[9];
#pragma unroll
            for (int ci = 0; ci < 9; ++ci) acc[ci] = (f32x4){0.f, 0.f, 0.f, 0.f};
#pragma unroll 4
            for (int it = 0; it < 64; ++it) { const f32x4 wv = *(const f32x4*)(wp + (size_t)it * 4 * NMOD); const int k = wave * 256 + it * 4 + ks;
#pragma unroll
                for (int ci = 0; ci < 9; ++ci) acc[ci] = acc[ci] + wv * ST[ci * DM + k]; }
#pragma unroll
            for (int ci = 0; ci < 9; ++ci)
#pragma unroll
                for (int i = 0; i < 4; ++i) { float v = acc[ci][i]; v += __shfl_xor(v, 16); v += __shfl_xor(v, 32); acc[ci][i] = v; }
            if (lane < 16) {
#pragma unroll
                for (int ci = 0; ci < 9; ++ci) *(LAS f32x4*)(RED + (wave * 16 + cq) * 36 + ci * 4) = acc[ci]; }
            __syncthreads();
            for (int t = tid; t < 576; t += 512) { const int ci = t >> 6, col = t & 63; float s = ada_b[l * NMOD + col0 + col];
#pragma unroll
                for (int w = 0; w < 8; ++w) s += RED[(w * 16 + (col >> 2)) * 36 + ci * 4 + (col & 3)];
                MOD[(size_t)(l * 9 + ci) * NMOD + col0 + col] = s; }
            __syncthreads();
        }
    }
    __syncthreads();
    {
        LAS float* scr = (LAS float*)(lds + wave * 16384);
        const int gw = bx * 8 + wave, NGW = G * 8;
        constexpr int I_POOL = 8 * 128, I_SIN = 32 * 128, I_SOUT = 32 * 64, I_QKV = 32 * 192, I_WO = 32 * 64, I_FIN = 4 * 32 * 352, I_FOUT = 4 * 88 * 64;
        constexpr int NITEMS = I_POOL + I_SIN + I_SOUT + I_QKV + I_WO + I_FIN + I_FOUT;
        for (int it = gw; it < NITEMS; it += NGW) {
            int r = it;
            if (r < I_POOL) { const int mat = r >> 7, q = r & 127, kb = q >> 4, nb = q & 15;
                transpose_item(AIN(10) + (size_t)mat * 512 * 512, 512, 512, (bf16_t*)(ws + WS_POOLW) + (size_t)mat * 512 * 512, kb * 64, nb * 32, nb * 32, scr, lane); continue; } r -= I_POOL;
            if (r < I_SIN) { const int kb = r >> 7, nb = r & 127; transpose_item(AIN(12), DM, 4096, (bf16_t*)(ws + WS_SGUIN), kb * 64, nb * 32, nb * 32, scr, lane); continue; } r -= I_SIN;
            if (r < I_SOUT) { const int kb = r >> 6, nb = r & 63; transpose_item(AIN(16), DM, DM, (bf16_t*)(ws + WS_SGUOUT), kb * 64, nb * 32, nb * 32, scr, lane); continue; } r -= I_SOUT;
            if (r < I_QKV) { const int kb = r / 192, nb = r % 192; transpose_item(AIN(17), DM, 6144, (bf16_t*)(ws + WS_WQKV), kb * 64, nb * 32, qkv_drow(nb * 32), scr, lane); continue; } r -= I_QKV;
            if (r < I_WO) { const int kb = r >> 6, nb = r & 63; transpose_item(AIN(20), DM, DM, (bf16_t*)(ws + WS_WO), kb * 64, nb * 32, nb * 32, scr, lane); continue; } r -= I_WO;
            if (r < I_FIN) { const int l = r / (32 * 352), q = r % (32 * 352), kb = q / 352, nb = q % 352;
                transpose_item(AIN(21) + (size_t)l * DM * 2 * FFH, DM, 2 * FFH, (bf16_t*)(ws + WS_FFNIN + (size_t)l * FFNIN_L), kb * 64, nb * 32, ffnin_drow(nb * 32), scr, lane); continue; } r -= I_FIN;
            { const int l = r / (88 * 64), q = r % (88 * 64), kb = q >> 6, nb = q & 63;
                transpose_item(AIN(22) + (size_t)l * FFH * DM, FFH, DM, (bf16_t*)(ws + WS_FFNOUT + (size_t)l * FFNOUT_L), kb * 64, nb * 32, nb * 32, scr, lane); }
        }
    }
    {
        const size_t gt = (size_t)bx * 512 + tid, NT = (size_t)G * 512;
        for (size_t i = gt; i < 8 * 128 * 128 / 8; i += NT) { const float* src = AIN(14) + i * 8; const f32x4 v0 = *(const f32x4*)src, v1 = *(const f32x4*)(src + 4);
            u32x4 w; w.x = cvt_pk_bf16(v0.x, v0.y); w.y = cvt_pk_bf16(v0.z, v0.w); w.z = cvt_pk_bf16(v1.x, v1.y); w.w = cvt_pk_bf16(v1.z, v1.w); *(u32x4*)((bf16_t*)(ws + WS_SGUWS) + i * 8) = w; }
        for (size_t i = gt; i < 64 * 32; i += NT) { const int pos = (int)(i >> 5), f = (int)(i & 31);
            const float inv = powf(10000.0f, -(float)f / 32.0f); const float angf = (float)pos * inv; const double ang = (double)angf;
            const double kq = rint(ang * 0.6366197723675814); double r = fma(-kq, 1.5707963267948966, ang); r = fma(-kq, 6.123233995736766e-17, r);
            const int q = ((int)kq) & 3; const double r2 = r * r;
            const double sn = r * (1.0 + r2 * (-1.0 / 6 + r2 * (1.0 / 120 + r2 * (-1.0 / 5040 + r2 * (1.0 / 362880 + r2 * (-1.0 / 39916800 + r2 * (1.0 / 6227020800.0)))))));
            const double cs = 1.0 + r2 * (-0.5 + r2 * (1.0 / 24 + r2 * (-1.0 / 720 + r2 * (1.0 / 40320 + r2 * (-1.0 / 3628800 + r2 * (1.0 / 479001600.0 + r2 * (-1.0 / 87178291200.0)))))));
            const double sv = (q == 0) ? sn : (q == 1) ? cs : (q == 2) ? -sn : -cs, cv = (q == 0) ? cs : (q == 1) ? -sn : (q == 2) ? -cs : sn;
            float* rp = (float*)(ws + WS_ROPE) + i * 2; rp[0] = (float)cv; rp[1] = (float)sv; }
    }
    rowop_phase<0>(G, bx, AIN(0), AIN(1), nullptr, nullptr, nullptr, (float*)(ws + WS_RSTD), nullptr, nullptr);
#undef AIN
}

__device__ __forceinline__ void cache_convert(CArgs* ap, int G, int bx) {
    CArgs& a = *ap;
    unsigned char* ws = (unsigned char*)a.ws;
    const int tid = opaque_tid();
    const size_t gt = (size_t)bx * 512 + tid, NT = (size_t)G * 512;
    const size_t NC8 = (size_t)8 * PAST * DM / 8;
    for (size_t i = gt; i < 2 * NC8; i += NT) { const bool isv = i >= NC8; const size_t j = isv ? i - NC8 : i; const size_t e = j * 8, b = e / ((size_t)PAST * DM), rem = e % ((size_t)PAST * DM);
        const float* src = (const float*)(isv ? a.in[3] : a.in[2]) + e; bf16_t* dst = (bf16_t*)(ws + (isv ? WS_VALL : WS_KALL)) + b * (size_t)KVLEN * DM + rem;
        const f32x4 v0 = *(const f32x4*)src, v1 = *(const f32x4*)(src + 4);
        u32x4 w; w.x = cvt_pk_bf16(v0.x, v0.y); w.y = cvt_pk_bf16(v0.z, v0.w); w.z = cvt_pk_bf16(v1.x, v1.y); w.w = cvt_pk_bf16(v1.z, v1.w); *(u32x4*)dst = w; }
}

__device__ __forceinline__ CArgs* kargs() { CArgs* p = (CArgs*)__builtin_amdgcn_kernarg_segment_ptr(); asm volatile("" : "+s"(p)); return p; }
#define KA (kargs())
__global__ void __launch_bounds__(512, 2) mk_fwd(Args a_unused) {
    extern __shared__ __attribute__((aligned(16))) unsigned char lds_raw[];
    LAS unsigned char* lds = (LAS unsigned char*)lds_raw;
    volatile LAS unsigned* MISC = (volatile LAS unsigned*)(lds + MISC_OFF);
    const int tid = threadIdx.x, lane = tid & 63, wave = __builtin_amdgcn_readfirstlane(tid >> 6);
    const int G0 = gridDim.x, bx0 = blockIdx.x;
    const int vcu0 = (G0 % 8 == 0) ? (bx0 % 8) * (G0 / 8) + bx0 / 8 : bx0;
    GAS unsigned char* ws0 = KA->ws;
    unsigned* ctl = (unsigned*)((unsigned char*)ws0 + WS_CTL);
    for (int u = tid; u < (LDS_BYTES - LDSCTL_OFF) / 4; u += 512) ((LAS unsigned*)(lds + LDSCTL_OFF))[u] = 0u;
    __syncthreads();
    XcdBarrier bar = xcd_barrier_post(ctl + CW_BAR + KA->li * XCD_BAR_WORDS, MISC + 8);
#if MK_ONE_LAUNCH
    constexpr int lo = 0, hi = NPH;
#else
    const int lo = KA->ph_lo, hi = KA->ph_hi;
#endif
#ifndef MK_MASK
#define MK_MASK 0xffff
#endif
#define EN(b) ((MK_MASK >> (b)) & 1)
#define IN(k) (lo <= (k) && (k) < hi)
#define SEAM(k) do { if ((k) + 1 < hi) { XcdBarrier b2_ = bar; asm volatile("" : "+s"(b2_.bar), "+s"(b2_.x)); xcd_barrier(b2_); } } while (0)

#define PHASE_BEGIN \
    int G = G0, bx = bx0, vcu = vcu0; GAS unsigned char* wsg = ws0; asm volatile("" : "+s"(G), "+s"(bx), "+s"(vcu), "+s"(wsg)); unsigned char* ws = (unsigned char*)wsg; \
    bf16_t* X = (bf16_t*)(ws + WS_X); float* MOD = (float*)(ws + WS_MOD); float* RSTD = (float*)(ws + WS_RSTD); \
    float* SSQ = (float*)(ws + WS_SSQ); float* SW = (float*)(ws + WS_SW); \
    bf16_t* Hb = (bf16_t*)(ws + WS_H); bf16_t* HID = (bf16_t*)(ws + WS_HID); \
    bf16_t* R3 = (bf16_t*)((float*)KA->out); \
    (void)vcu; (void)RSTD; (void)SSQ; (void)SW; (void)Hb; (void)HID; (void)R3; (void)MOD; (void)X;
#define LAYER_VARS \
    const int kind = (l == 3) ? 0 : l; const float* modl = MOD + (size_t)l * 9 * NMOD; \
    const float* xs0 = (const float*)KA->in[0]; const float* xs1 = (const float*)KA->in[1]; const bf16_t* xs16 = (l == 0) ? (const bf16_t*)nullptr : (const bf16_t*)X; \
    const float* gmix = ((const float*)KA->in[8]) + l * DM; const float* gffn = ((const float*)KA->in[9]) + l * DM; \
    (void)kind; (void)modl; (void)xs0; (void)xs1; (void)xs16; (void)gmix; (void)gffn;

    if (EN(0) && IN(0)) { PHASE_BEGIN prologue(lds, KA, G, bx); SEAM(0); }

    for (int l = 0; l < 4; ++l) {
        const int pb = 1 + 5 * l;
        if (IN(pb + 0)) { PHASE_BEGIN LAYER_VARS
            if (kind == 0) { if (EN(2)) {
                if (l == 0) {
#pragma unroll 1
                    for (int sidx = 0; sidx < 6; ++sidx) {
                        const bf16_t* Wt = (sidx < 4) ? (const bf16_t*)(ws + WS_FFNIN + (size_t)sidx * FFNIN_L) : (sidx == 4) ? (const bf16_t*)(ws + WS_SGUIN) : (const bf16_t*)(ws + WS_WQKV);
                        const int N = (sidx < 4) ? 2 * FFH : (sidx == 4) ? 4096 : 6144;
                        const float* shp = (sidx < 4) ? MOD + (size_t)sidx * 9 * NMOD + 3 * DM : MOD + (size_t)(sidx - 3) * 9 * NMOD;
                        float* outp = SW + ((sidx < 4) ? sidx * SW_G1_L : (sidx == 4) ? SW_SGU : SW_QKV);
                        sw_compute(lds, G, bx, Wt, N, shp, outp);
                    }
                    __syncthreads();
                }
                if (l == 0) pool_phase<false>(lds, G, bx, xs0, xs1, xs16, RSTD, (const float*)nullptr, gmix, modl + 1 * DM, HID);
                else pool_phase<true>(lds, G, bx, xs0, xs1, xs16, RSTD, (const float*)SSQ, gmix, modl + 1 * DM, HID); } }
            else if (kind == 1) { if (EN(3)) { const pg8::Gemm g = pg8::mk_gemm(Hb, (const bf16_t*)(ws + WS_SGUIN), DM, DM); pg8::StaticOrder S; S.init(MROWS, 4096, G, bx);
                pg8::EpiGelu E{HID, (float*)(ws + WS_VSS), SSQ, SW + SW_SGU}; pg8::gemm_phase(lds, g, S, E); } }
            else if (EN(4)) { cache_convert(KA, G, bx);
                const pg8::Gemm g = pg8::mk_gemm(Hb, (const bf16_t*)(ws + WS_WQKV), DM, DM); pg8::StaticOrder S; S.init(MROWS, 6144, G, bx);
                pg8::EpiQKV E{(bf16_t*)(ws + WS_Q), (bf16_t*)(ws + WS_KALL), (bf16_t*)(ws + WS_VALL), (bf16_t*)(ws + WS_KC), (bf16_t*)(ws + WS_VC),
                              ((float*)KA->out) + (size_t)MROWS * DM, ((float*)KA->out) + (size_t)MROWS * DM + (size_t)NCTX * DM, (const float*)(ws + WS_ROPE), SSQ, SW + SW_QKV};
                pg8::gemm_phase(lds, g, S, E); }
            SEAM(pb + 0);
        }
        if (IN(pb + 1)) { PHASE_BEGIN LAYER_VARS
            if (kind == 0) { if (EN(5)) { const int slot = l / 3; const pg8::Gemm g = pg8::mk_gemm(HID, (const bf16_t*)(ws + WS_POOLW) + (size_t)slot * DM * 512, DM, 512, 512); pg8::StaticOrder S; S.init(MROWS, DM, G, bx);
                pg8::EpiRes E{xs0, xs1, xs16, X, modl + 2 * DM, ((const float*)KA->in[11]) + slot * DM, SSQ, Hb, gffn, modl + 4 * DM}; pg8::gemm_phase(lds, g, S, E); } }
            else if (kind == 1) { if (EN(6)) sgu_phase(lds, G, bx, HID, (const float*)(ws + WS_VSS), ((const float*)KA->in[13]), (const bf16_t*)(ws + WS_SGUWS), ((const float*)KA->in[15]), R3); }
            else if (EN(7)) attn_phase(lds, G, vcu, (const bf16_t*)(ws + WS_Q), R3, (const bf16_t*)(ws + WS_KC), (const bf16_t*)(ws + WS_VC), (const bf16_t*)(ws + WS_KALL), (const bf16_t*)(ws + WS_VALL),
                            (float*)(ws + WS_ATTS), ((const float*)KA->in[18]), ((const float*)KA->in[19]));
            SEAM(pb + 1);
        }
        if (EN(8) && IN(pb + 2) && phase_nonempty(pb + 2)) { PHASE_BEGIN LAYER_VARS
            { const pg8::Gemm g = pg8::mk_gemm(R3, (const bf16_t*)(ws + (kind == 1 ? WS_SGUOUT : WS_WO)), DM, DM); pg8::StaticOrder S; S.init(MROWS, DM, G, bx);
                pg8::EpiRes E{nullptr, nullptr, X, X, modl + 2 * DM, nullptr, SSQ, Hb, gffn, modl + 4 * DM}; pg8::gemm_phase(lds, g, S, E); }
            SEAM(pb + 2);
        }
        if (EN(10) && IN(pb + 3)) { PHASE_BEGIN LAYER_VARS const pg8::Gemm g = pg8::mk_gemm(Hb, (const bf16_t*)(ws + WS_FFNIN + (size_t)l * FFNIN_L), DM, DM); pg8::StaticOrder S; S.init(MROWS, 2 * FFH, G, bx);
            pg8::EpiSwiglu E{HID, SSQ, SW + l * SW_G1_L}; pg8::gemm_phase(lds, g, S, E); SEAM(pb + 3); }
        if (EN(11) && IN(pb + 4)) { PHASE_BEGIN LAYER_VARS const pg8::Gemm g{HID, (const bf16_t*)(ws + WS_FFNOUT + (size_t)l * FFNOUT_L), 64, FFH, 0, 256u * 64u * 2u, (size_t)(FFH / 64) * 256 * 64 * 2}; pg8::StaticOrder S; S.init(MROWS, DM, G, bx, 4);
            const bool nxg = (l == 0 || l == 1);
            pg8::EpiRes E{nullptr, nullptr, X, X, modl + 5 * DM, nullptr, (l == 3) ? (float*)nullptr : SSQ, nxg ? Hb : (bf16_t*)nullptr, ((const float*)KA->in[8]) + (l + 1) * DM, MOD + (size_t)(l + 1) * 9 * NMOD + 1 * DM};
            if (l == 3) { pg8::EpiDelta ED{Hb, modl + 5 * DM, nullptr}; pg8::gemm_phase(lds, g, S, ED); }
            else pg8::gemm_phase(lds, g, S, E);
            SEAM(pb + 4); }
    }
    if (EN(12) && IN(21)) { PHASE_BEGIN rowop_phase<2>(G, bx, (const float*)X, nullptr, ((const float*)KA->in[23]), nullptr, nullptr, nullptr, Hb, ((float*)KA->out)); }
#undef PHASE_BEGIN
#undef LAYER_VARS
#undef IN
#undef SEAM
}

extern "C" void kernel_launch(void* const* d_in, const int* in_sizes, int n_in, void* d_out, int out_size, void* d_ws, size_t ws_size, hipStream_t stream) {
    static int grid = 0;
    if (grid == 0) {
        if (n_in != 24 || in_sizes[0] != NCTX * DM || in_sizes[1] != NLAT * DM || ws_size < WS_END) {
            fprintf(stderr, "kernel_launch: unexpected shapes: n_in %d in0 %d in1 %d out %d ws %zu (need %zu)\n", n_in, n_in > 0 ? in_sizes[0] : -1, n_in > 1 ? in_sizes[1] : -1, out_size, ws_size, (size_t)WS_END); grid = -1; return; }
        int dev = 0, cus = 0;
        if (hipGetDevice(&dev) != hipSuccess || hipDeviceGetAttribute(&cus, hipDeviceAttributeMultiprocessorCount, dev) != hipSuccess) { grid = -1; return; }
        if (hipFuncSetAttribute((const void*)mk_fwd, hipFuncAttributeMaxDynamicSharedMemorySize, LDS_BYTES) != hipSuccess) { fprintf(stderr, "kernel_launch: hipFuncSetAttribute failed\n"); grid = -1; return; }
        int per_cu = 0;
        if (hipOccupancyMaxActiveBlocksPerMultiprocessor(&per_cu, (const void*)mk_fwd, 512, LDS_BYTES) != hipSuccess || per_cu < 1) { fprintf(stderr, "kernel_launch: occupancy query says %d\n", per_cu); }
        (void)hipGetLastError();
        grid = cus > 0 ? cus : 256;
    }
    if (grid < 0) return;
    (void)hipMemsetAsync((char*)d_ws + WS_CTL, 0, CTL_ZERO_BYTES, stream);
    Args a{};
    for (int i = 0; i < 24; ++i) a.in[i] = (const float*)d_in[i];
    a.out = (float*)d_out; a.ws = (unsigned char*)d_ws; a.pad = 0;
#if MK_ONE_LAUNCH
    a.ph_lo = 0; a.ph_hi = NPH; a.li = 0;
    hipLaunchKernelGGL(mk_fwd, dim3(grid), dim3(512), LDS_BYTES, stream, a);
#else
    int li = 0;
    for (int p = 0; p < NPH; ++p) { if (!phase_nonempty(p)) continue; a.ph_lo = p; a.ph_hi = p + 1; a.li = li++;
        hipLaunchKernelGGL(mk_fwd, dim3(grid), dim3(512), LDS_BYTES, stream, a); }
#endif
    const hipError_t le = hipPeekAtLastError();
    if (le != hipSuccess) fprintf(stderr, "kernel_launch: launch failed: %s\n", hipGetErrorName(le));
}
```

```cpp
#include <hip/hip_runtime.h>
#include <hip/hip_bf16.h>
#include <cstdio>
#include <cstdint>

#ifndef MK_ONE_LAUNCH
#define MK_ONE_LAUNCH 1
#endif

#define GAS __attribute__((address_space(1)))
#define LAS __attribute__((address_space(3)))
typedef unsigned short bf16_t;
typedef short bf16x8 __attribute__((ext_vector_type(8)));
typedef short s16x4 __attribute__((ext_vector_type(4)));
typedef float f32x4 __attribute__((ext_vector_type(4)));
typedef float f32x2 __attribute__((ext_vector_type(2)));
typedef float f32x16 __attribute__((ext_vector_type(16)));
typedef unsigned u32x4 __attribute__((ext_vector_type(4)));
typedef unsigned u32x2 __attribute__((ext_vector_type(2)));

constexpr int DM = 2048, NCTX = 8192, NLAT = 32768, MROWS = NCTX + NLAT, FFH = 5632, NMOD = 6 * DM;
constexpr int LATSEQ = 4096, CTXSEQ = 256, PAST = 256, KVLEN = PAST + LATSEQ;
constexpr float EPS = 1e-6f;
constexpr float LAM_INIT = 0.47071301834358416f;

constexpr size_t MiB = 1u << 20;
constexpr size_t WS_CTL = 0, CTL_ZERO_BYTES = 1 * MiB;
constexpr size_t WS_MOD = 1 * MiB;
constexpr size_t WS_ROPE = 3 * MiB;
constexpr size_t WS_RSTD = 4 * MiB;
constexpr size_t WS_VSS = 5 * MiB;
constexpr size_t WS_SGUWS = 10 * MiB;
constexpr size_t WS_POOLW = 11 * MiB;
constexpr size_t WS_SGUIN = 15 * MiB;
constexpr size_t WS_SGUOUT = 31 * MiB;
constexpr size_t WS_WQKV = 39 * MiB;
constexpr size_t WS_WO = 63 * MiB;
constexpr size_t WS_FFNIN = 71 * MiB;
constexpr size_t WS_FFNOUT = 247 * MiB;
constexpr size_t WS_X = 336 * MiB;
constexpr size_t WS_H = 656 * MiB;
constexpr size_t WS_HID = 816 * MiB;
constexpr size_t WS_Q = 816 * MiB;
constexpr size_t WS_KALL = 976 * MiB;
constexpr size_t WS_VALL = 1112 * MiB;
constexpr size_t WS_KC = 1248 * MiB;
constexpr size_t WS_VC = 1280 * MiB;
constexpr size_t WS_ATTS = 1312 * MiB;
constexpr size_t WS_SSQ = 1376 * MiB;
constexpr size_t WS_SW = 1381 * MiB;
constexpr size_t WS_END = 1384 * MiB;
constexpr int SW_G1_L = 9 * 2 * FFH, SW_SGU = 4 * SW_G1_L, SW_QKV = SW_SGU + 9 * 4096, SW_TOTAL = SW_QKV + 9 * 6144;
static_assert((size_t)SW_TOTAL * 4 <= 2 * MiB, "shift@W tables");
constexpr size_t FFNIN_L = (size_t)2 * FFH * DM * 2, FFNOUT_L = (size_t)DM * FFH * 2;

constexpr int CW_BAR = 4096;

constexpr int RING_BYTES = 131072;
constexpr int LDS_BYTES = 163840;
constexpr int LDSCTL_OFF = LDS_BYTES - 256, MISC_OFF = LDSCTL_OFF;
constexpr int RT_OFF = RING_BYTES, TAB_FLOATS = 512, SSX_FLOATS = 1024, STG_FLOAT_OFF = 2 * 512 + 2 * 1024;
constexpr int RT_DOC = 0;

constexpr int NPH = 22;
__host__ __device__ inline bool phase_nonempty(int p) { return !(p == 3 || p == 18); }

__device__ __forceinline__ unsigned cvt_pk_bf16(float lo, float hi) { unsigned r; asm volatile("v_cvt_pk_bf16_f32 %0, %1, %2" : "=v"(r) : "v"(lo), "v"(hi)); return r; }
__device__ __forceinline__ f32x4 bf4_to_f4(u32x2 d) { return (f32x4){__uint_as_float(d.x << 16), __uint_as_float(d.x & 0xffff0000u), __uint_as_float(d.y << 16), __uint_as_float(d.y & 0xffff0000u)}; }
typedef _Float16 h16x2 __attribute__((ext_vector_type(2)));
typedef _Float16 h16x4 __attribute__((ext_vector_type(4)));
__device__ __forceinline__ unsigned pk_f16(float a, float b) { const h16x2 h = __builtin_convertvector((f32x2){a, b}, h16x2); return __builtin_bit_cast(unsigned, h); }
__device__ __forceinline__ f32x4 h4_to_f4(u32x2 d) { const h16x4 h = __builtin_bit_cast(h16x4, d); return __builtin_convertvector(h, f32x4); }
__device__ __forceinline__ float bf2f(bf16_t b) { return __uint_as_float(((unsigned)b) << 16); }
__device__ __forceinline__ bf16_t f2bf(float f) { return (bf16_t)(cvt_pk_bf16(f, 0.f) & 0xffffu); }
__device__ __forceinline__ int opaque_tid() { int t = threadIdx.x; asm volatile("" : "+v"(t)); return t; }
__device__ __forceinline__ float add_xor1(float x) { return x + __builtin_bit_cast(float, __builtin_amdgcn_update_dpp(0, __builtin_bit_cast(int, x), 0xB1, 0xF, 0xF, true)); }
__device__ __forceinline__ float add_xor2(float x) { return x + __builtin_bit_cast(float, __builtin_amdgcn_update_dpp(0, __builtin_bit_cast(int, x), 0x4E, 0xF, 0xF, true)); }
__device__ __forceinline__ float add_xor16(float x) { return x + __builtin_bit_cast(float, __builtin_amdgcn_ds_swizzle(__builtin_bit_cast(int, x), 0x401F)); }
__device__ __forceinline__ float add_xor32(float x) { auto r = __builtin_amdgcn_permlane32_swap(__builtin_bit_cast(unsigned, x), __builtin_bit_cast(unsigned, x), false, false); return __uint_as_float(r[0]) + __uint_as_float(r[1]); }
__device__ __forceinline__ float wave_sum(float v) {
    v = add_xor1(v); v = add_xor2(v);
    v += __builtin_bit_cast(float, __builtin_amdgcn_update_dpp(0, __builtin_bit_cast(int, v), 0x141, 0xF, 0xF, true));
    v += __builtin_bit_cast(float, __builtin_amdgcn_update_dpp(0, __builtin_bit_cast(int, v), 0x140, 0xF, 0xF, true));
    v = add_xor16(v); return add_xor32(v);
}
__device__ __forceinline__ float dot4(f32x4 a) { return (a.x * a.x + a.y * a.y) + (a.z * a.z + a.w * a.w); }

namespace pg8 {
constexpr int BM = 256, BK = 64, HALF = 128, HTB = HALF * BK * 2, STAGE_BYTES = 8 * HTB, NXCD = 8;
__host__ __device__ __forceinline__ int lds_byte(int r, int c) { const int st = (r >> 4) * 2 + (c >> 5), rr = r & 15, cc = c & 31, ob = rr * 64 + cc * 2; return st * 1024 + (ob ^ (((ob >> 9) & 1) << 5)); }
__host__ __device__ __forceinline__ void stage_rc(int b, int& R, int& C) { const int st = b / 1024, sb = b % 1024, swz = sb ^ (((sb >> 9) & 1) << 5); R = (st >> 1) * 16 + swz / 64; C = (st & 1) * 32 + (swz % 64) / 2; }
__host__ __device__ __forceinline__ int perm32(int rho) { const int n = rho >> 4, i = rho & 15; return 8 * (i >> 2) + 4 * n + (i & 3); }

struct Unit { int pm, pn; };
struct Gemm { const bf16_t* A; const bf16_t* Bt; int lda, K, agrp; unsigned kstepA; size_t tstepA; };
__host__ __device__ __forceinline__ Gemm mk_gemm(const bf16_t* A, const bf16_t* Bt, int lda, int K, int agrp = 0) { return Gemm{A, Bt, lda, K, agrp, (unsigned)(BK * 2), (size_t)BM * lda * 2}; }

struct StaticOrder {
    int nM, nN, nwg, G, c, WGM, rev;
    __host__ __device__ void init(int M, int N, int G_, int c_, int wgm = 8, int rev_ = 0) { nM = M / BM; nN = N / BM; nwg = nM * nN; G = G_; c = c_; WGM = wgm; rev = rev_; }
    __host__ __device__ bool next(int i, Unit& u) const {
        const long L = (long)i * G + c; if (L >= nwg) return false;
        int wgid = (int)L; { const int q = nwg / NXCD, r = nwg % NXCD, xcd = wgid % NXCD, off = wgid / NXCD; wgid = (xcd < r ? xcd * (q + 1) : r * (q + 1) + (xcd - r) * q) + off; }
        const int nig = WGM * nN, gid = wgid / nig, fm = gid * WGM, gsz = (nM - fm) < WGM ? (nM - fm) : WGM;
        u.pm = fm + ((wgid % nig) % gsz); u.pn = (wgid % nig) / gsz; if (rev) u.pm = nM - 1 - u.pm; return true;
    }
};

__device__ __forceinline__ f32x2 gelu_pk(f32x2 v) {
    const f32x2 av = __builtin_elementwise_abs(v), d = av * 0.2316418882f + 1.0f;
    f32x2 t; t.x = __builtin_amdgcn_rcpf(d.x); t.y = __builtin_amdgcn_rcpf(d.y);
    f32x2 q = t * 0.5307027145f + (-0.7265760135f); q = q * t + 0.7107068705f; q = q * t + (-0.142248368f); q = q * t + 0.127414796f; q = q * t;
    const f32x2 s = (v * v) * (-0.72134752044f);
    f32x2 e; e.x = __builtin_amdgcn_exp2f(s.x); e.y = __builtin_amdgcn_exp2f(s.y);
    const f32x2 m = v * (q * e), r = v - m;
    f32x2 o; o.x = v.x < 0.f ? m.x : r.x; o.y = v.y < 0.f ? m.y : r.y; return o;
}

__device__ __forceinline__ int ci_of_pm(int pm) { return pm < 32 ? 8 : ((pm - 32) >> 4); }


struct EpiRes {
    static constexpr bool PERM = true, HAS_PREF = true;
    const float* xin0; const float* xin1;
    const bf16_t* xin16;
    bf16_t* xout; const float* gate;
    const float* cscale;
    float* ssq; bf16_t* xg; const float* gnext; const float* scnext;
    __device__ __forceinline__ void pref_direct(const Unit& u, LAS float* tab, int tid) const {
        if (tid < 64) { const int ci = ci_of_pm(u.pm), c4 = u.pn * BM + tid * 4; f32x4 g = *(const f32x4*)(gate + (size_t)ci * NMOD + c4);
            if (cscale) g = g * *(const f32x4*)(cscale + c4);
            *(LAS f32x4*)(tab + tid * 4) = g;
            if (xg) *(LAS f32x4*)(tab + 256 + tid * 4) = *(const f32x4*)(gnext + c4) * (*(const f32x4*)(scnext + (size_t)ci * NMOD + c4) + 1.0f); }
    }
    __device__ __forceinline__ void pref_dma(const Unit& u, LAS float* stg, int wid, int lane) const {
        const int ci = ci_of_pm(u.pm), c4 = u.pn * BM + lane * 4, v = wid & 3;
        const float* gsrc = gate + (size_t)ci * NMOD;
        const float* src = (v == 0) ? gsrc : (v == 1) ? (cscale ? cscale : gsrc) : (v == 2) ? (xg ? gnext : gsrc) : (xg ? scnext + (size_t)ci * NMOD : gsrc);
        __builtin_amdgcn_global_load_lds((const unsigned*)(src + c4), (LAS unsigned*)(stg + v * 256), 16, 0, 0);
    }
    __device__ __forceinline__ void pref_commit(const LAS float* stg, LAS float* tab, int tid) const {
        if (tid < 64) { f32x4 g = *(const LAS f32x4*)(stg + tid * 4); if (cscale) g = g * *(const LAS f32x4*)(stg + 256 + tid * 4);
            *(LAS f32x4*)(tab + tid * 4) = g;
            if (xg) *(LAS f32x4*)(tab + 256 + tid * 4) = *(const LAS f32x4*)(stg + 512 + tid * 4) * (*(const LAS f32x4*)(stg + 768 + tid * 4) + 1.0f); }
    }
    __device__ __forceinline__ void operator()(const f32x4 (&acc)[2][2][4][2], const Unit& u, int wr, int wc, int fr, int fq, const LAS float* tab, LAS float* ssx) const {
        const int row0 = u.pm * BM + wr * 64 + fr, col0 = u.pn * BM + wc * 32 + 8 * fq;
        const LAS float* tg = tab + wc * 32 + 8 * fq;
        const float* xb = (u.pm < 32) ? xin0 : xin1; const int radj = (u.pm < 32) ? 0 : NCTX;
#define RES_BODY(ai, m0, NM, XLOAD0, XLOAD1) \
            _Pragma("unroll") for (int m_ = 0; m_ < NM; ++m_) { const int m = (m0) + m_; const int row = row0 + (ai) * HALF + m * 16; bf16_t* xo = xout + (size_t)row * DM + col0; float ss = 0.f; \
                _Pragma("unroll") for (int bj = 0; bj < 2; ++bj) { const f32x4 g0 = *(const LAS f32x4*)(tg + bj * HALF), g1 = *(const LAS f32x4*)(tg + bj * HALF + 4); \
                    const f32x4 x0 = (XLOAD0) + g0 * acc[ai][bj][m][0], x1 = (XLOAD1) + g1 * acc[ai][bj][m][1]; \
                    { u32x4 w; w.x = pk_f16(x0[0], x0[1]); w.y = pk_f16(x0[2], x0[3]); w.z = pk_f16(x1[0], x1[1]); w.w = pk_f16(x1[2], x1[3]); *(u32x4*)(xo + bj * HALF) = w; } \
                    ss += dot4(x0) + dot4(x1); \
                    if (xg) { const f32x4 h0 = x0 * *(const LAS f32x4*)(tg + 256 + bj * HALF), h1 = x1 * *(const LAS f32x4*)(tg + 256 + bj * HALF + 4); \
                        u32x4 w; w.x = cvt_pk_bf16(h0[0], h0[1]); w.y = cvt_pk_bf16(h0[2], h0[3]); w.z = cvt_pk_bf16(h1[0], h1[1]); w.w = cvt_pk_bf16(h1[2], h1[3]); \
                        *(u32x4*)(xg + (size_t)row * DM + col0 + bj * HALF) = w; } } \
                if (ssq) { ss = add_xor16(ss); ss = add_xor32(ss); if (fq == 0) ssx[((ai) * HALF + wr * 64 + m * 16 + fr) * 4 + wc] = ss; } }
#define RES_ROWS32(ai, m0, NM) do { f32x4 xv[NM][2][2]; \
            _Pragma("unroll") for (int m_ = 0; m_ < NM; ++m_) { const float* xr = xb + (size_t)(row0 + (ai) * HALF + ((m0) + m_) * 16 - radj) * DM + col0; \
                _Pragma("unroll") for (int bj = 0; bj < 2; ++bj) _Pragma("unroll") for (int n = 0; n < 2; ++n) xv[m_][bj][n] = *(const f32x4*)(xr + bj * HALF + n * 4); } \
            RES_BODY(ai, m0, NM, xv[m_][bj][0], xv[m_][bj][1]) } while (0)
#define RES_ROWS16(ai, m0, NM) do { u32x4 xv[NM][2]; \
            _Pragma("unroll") for (int m_ = 0; m_ < NM; ++m_) { const bf16_t* xr = xin16 + (size_t)(row0 + (ai) * HALF + ((m0) + m_) * 16) * DM + col0; \
                _Pragma("unroll") for (int bj = 0; bj < 2; ++bj) xv[m_][bj] = *(const u32x4*)(xr + bj * HALF); } \
            RES_BODY(ai, m0, NM, h4_to_f4((u32x2){xv[m_][bj].x, xv[m_][bj].y}), h4_to_f4((u32x2){xv[m_][bj].z, xv[m_][bj].w})) } while (0)
        if (xin16) { RES_ROWS16(0, 0, 4); RES_ROWS16(1, 0, 4); }
        else { RES_ROWS32(0, 0, 4); RES_ROWS32(1, 0, 4); }
#undef RES_ROWS32
#undef RES_ROWS16
#undef RES_BODY
    }
    __device__ __forceinline__ void post(const Unit& u, const LAS float* ssx, int tid) const {
        if (ssq && tid < 256) { const f32x4 v = *(const LAS f32x4*)(ssx + tid * 4); int t4 = tid; asm volatile("" : "+v"(t4)); *(float*)((char*)(ssq + (size_t)u.pm * BM * 8 + u.pn) + (unsigned)t4 * 32u) = (v.x + v.y) + (v.z + v.w); }
    }
};

struct EpiDelta {
    static constexpr bool PERM = true, HAS_PREF = false;
    bf16_t* D; const float* gate; const float* cscale;
    __device__ __forceinline__ void pref_direct(const Unit&, LAS float*, int) const {}
    __device__ __forceinline__ void pref_dma(const Unit&, LAS float*, int, int) const {}
    __device__ __forceinline__ void pref_commit(const LAS float*, LAS float*, int) const {}
    __device__ __forceinline__ void post(const Unit&, const LAS float*, int) const {}
    __device__ __forceinline__ void operator()(const f32x4 (&acc)[2][2][4][2], const Unit& u, int wr, int wc, int fr, int fq, const LAS float*, LAS float*) const {
        const int ci = ci_of_pm(u.pm);
        const float* gp = gate + (size_t)ci * NMOD;
        const int row0 = u.pm * BM + wr * 64 + fr, col0 = u.pn * BM + wc * 32 + 8 * fq;
        f32x4 gv[2][2];
#pragma unroll
        for (int bj = 0; bj < 2; ++bj)
#pragma unroll
            for (int n = 0; n < 2; ++n) { gv[bj][n] = *(const f32x4*)(gp + col0 + bj * HALF + n * 4); if (cscale) gv[bj][n] = gv[bj][n] * *(const f32x4*)(cscale + col0 + bj * HALF + n * 4); }
#pragma unroll
        for (int ai = 0; ai < 2; ++ai)
#pragma unroll
            for (int m = 0; m < 4; ++m) { bf16_t* rowp = D + (size_t)(row0 + ai * HALF + m * 16) * DM + col0;
#pragma unroll
                for (int bj = 0; bj < 2; ++bj) { const f32x4 v0 = acc[ai][bj][m][0] * gv[bj][0], v1 = acc[ai][bj][m][1] * gv[bj][1];
                    u32x4 w; w.x = cvt_pk_bf16(v0[0], v0[1]); w.y = cvt_pk_bf16(v0[2], v0[3]); w.z = cvt_pk_bf16(v1[0], v1[1]); w.w = cvt_pk_bf16(v1[2], v1[3]);
                    *(u32x4*)(rowp + bj * HALF) = w; } }
    }
};

__device__ __forceinline__ void cons_pref_direct(const float* ssq, const float* sw, int N, const Unit& u, LAS float* tab, int tid) {
    const f32x4 part = *(const f32x4*)(ssq + ((size_t)u.pm * BM + (tid >> 1)) * 8 + (tid & 1) * 4);
    const float s_ = add_xor1((part.x + part.y) + (part.z + part.w));
    if ((tid & 1) == 0) tab[tid >> 1] = 1.0f / sqrtf(s_ * (1.0f / DM) + EPS);
    if (tid < 64) *(LAS f32x4*)(tab + 256 + tid * 4) = *(const f32x4*)(sw + (size_t)ci_of_pm(u.pm) * N + u.pn * BM + tid * 4);
}
__device__ __forceinline__ void cons_pref_dma(const float* ssq, const float* sw, int N, const Unit& u, LAS float* stg, int wid, int lane) {
    __builtin_amdgcn_global_load_lds((const unsigned*)(ssq + ((size_t)u.pm * BM + wid * 32) * 8 + lane * 4), (LAS unsigned*)(stg + wid * 256), 16, 0, 0);
    __builtin_amdgcn_global_load_lds((const unsigned*)(sw + (size_t)ci_of_pm(u.pm) * N + u.pn * BM + lane * 4), (LAS unsigned*)(stg + 2048), 16, 0, 0);
}
__device__ __forceinline__ void cons_pref_commit(const LAS float* stg, LAS float* tab, int tid) {
    const f32x4 part = *(const LAS f32x4*)(stg + (tid >> 1) * 8 + (tid & 1) * 4);
    const float s_ = add_xor1((part.x + part.y) + (part.z + part.w));
    if ((tid & 1) == 0) tab[tid >> 1] = 1.0f / sqrtf(s_ * (1.0f / DM) + EPS);
    if (tid < 64) *(LAS f32x4*)(tab + 256 + tid * 4) = *(const LAS f32x4*)(stg + 2048 + tid * 4);
}

struct EpiSwiglu {
    static constexpr bool PERM = true, HAS_PREF = true;
    bf16_t* O;
    const float* ssq;
    const float* sw;
    __device__ __forceinline__ void pref_direct(const Unit& u, LAS float* tab, int tid) const { cons_pref_direct(ssq, sw, 2 * FFH, u, tab, tid); }
    __device__ __forceinline__ void pref_dma(const Unit& u, LAS float* stg, int wid, int lane) const { cons_pref_dma(ssq, sw, 2 * FFH, u, stg, wid, lane); }
    __device__ __forceinline__ void pref_commit(const LAS float* stg, LAS float* tab, int tid) const { cons_pref_commit(stg, tab, tid); }
    __device__ __forceinline__ void post(const Unit&, const LAS float*, int) const {}
    __device__ __forceinline__ void operator()(const f32x4 (&acc)[2][2][4][2], const Unit& u, int wr, int wc, int fr, int fq, const LAS float* rt, LAS float*) const {
        bf16_t* blk = O + ((size_t)(u.pm * (FFH / 64) + 2 * u.pn + (wc >> 1)) * 256 + wr * 64 + fr) * 64 + (wc & 1) * 32 + 8 * fq;
        const LAS float* swp = rt + 256 + wc * 32 + 8 * fq;
        f32x4 sa[2], sb[2];
#pragma unroll
        for (int n = 0; n < 2; ++n) { sa[n] = *(const LAS f32x4*)(swp + 4 * n); sb[n] = *(const LAS f32x4*)(swp + HALF + 4 * n); }
#pragma unroll
        for (int ai = 0; ai < 2; ++ai)
#pragma unroll
            for (int m = 0; m < 4; ++m) { bf16_t* rowp = blk + (size_t)(ai * HALF + m * 16) * 64; const float rs = rt[ai * HALF + wr * 64 + m * 16 + fr];
                f32x4 r[2];
#pragma unroll
                for (int n = 0; n < 2; ++n) {
                    const f32x4 a = acc[ai][0][m][n] * rs + sa[n], b = acc[ai][1][m][n] * rs + sb[n];
                    const f32x4 e = a * -1.4426950408889634f;
                    f32x4 d; d.x = __builtin_amdgcn_exp2f(e.x); d.y = __builtin_amdgcn_exp2f(e.y); d.z = __builtin_amdgcn_exp2f(e.z); d.w = __builtin_amdgcn_exp2f(e.w);
                    d = d + 1.0f;
                    f32x4 sg; sg.x = __builtin_amdgcn_rcpf(d.x); sg.y = __builtin_amdgcn_rcpf(d.y); sg.z = __builtin_amdgcn_rcpf(d.z); sg.w = __builtin_amdgcn_rcpf(d.w);
                    r[n] = (a * b) * sg; }
                u32x4 w; w.x = cvt_pk_bf16(r[0].x, r[0].y); w.y = cvt_pk_bf16(r[0].z, r[0].w); w.z = cvt_pk_bf16(r[1].x, r[1].y); w.w = cvt_pk_bf16(r[1].z, r[1].w);
                *(u32x4*)rowp = w; }
    }
};

struct EpiGelu {
    static constexpr bool PERM = true, HAS_PREF = true;
    bf16_t* Z; float* vss; const float* ssq; const float* sw;
    __device__ __forceinline__ void pref_direct(const Unit& u, LAS float* tab, int tid) const { cons_pref_direct(ssq, sw, 4096, u, tab, tid); }
    __device__ __forceinline__ void pref_dma(const Unit& u, LAS float* stg, int wid, int lane) const { cons_pref_dma(ssq, sw, 4096, u, stg, wid, lane); }
    __device__ __forceinline__ void pref_commit(const LAS float* stg, LAS float* tab, int tid) const { cons_pref_commit(stg, tab, tid); }
    __device__ __forceinline__ void post(const Unit&, const LAS float*, int) const {}
    __device__ __forceinline__ void operator()(const f32x4 (&acc)[2][2][4][2], const Unit& u, int wr, int wc, int fr, int fq, const LAS float* rt, LAS float*) const {
        const int row0 = u.pm * BM + wr * 64 + fr, col0 = u.pn * BM + wc * 32 + 8 * fq;
        const LAS float* swp = rt + 256 + wc * 32 + 8 * fq;
        f32x4 sv[2][2];
#pragma unroll
        for (int bj = 0; bj < 2; ++bj)
#pragma unroll
            for (int n = 0; n < 2; ++n) sv[bj][n] = *(const LAS f32x4*)(swp + bj * HALF + 4 * n);
#pragma unroll
        for (int ai = 0; ai < 2; ++ai)
#pragma unroll
            for (int m = 0; m < 4; ++m) { const int row = row0 + ai * HALF + m * 16; bf16_t* rowp = Z + (size_t)row * 4096 + col0; float ss = 0.f; const float rs = rt[ai * HALF + wr * 64 + m * 16 + fr];
#pragma unroll
                for (int bj = 0; bj < 2; ++bj) { const f32x4 v0 = acc[ai][bj][m][0] * rs + sv[bj][0], v1 = acc[ai][bj][m][1] * rs + sv[bj][1];
                    const f32x2 a = gelu_pk((f32x2){v0[0], v0[1]}), b = gelu_pk((f32x2){v0[2], v0[3]}), c = gelu_pk((f32x2){v1[0], v1[1]}), d = gelu_pk((f32x2){v1[2], v1[3]});
                    ss += (a.x * a.x + a.y * a.y) + (b.x * b.x + b.y * b.y) + (c.x * c.x + c.y * c.y) + (d.x * d.x + d.y * d.y);
                    u32x4 w; w.x = cvt_pk_bf16(a.x, a.y); w.y = cvt_pk_bf16(b.x, b.y); w.z = cvt_pk_bf16(c.x, c.y); w.w = cvt_pk_bf16(d.x, d.y);
                    *(u32x4*)(rowp + bj * HALF) = w; }
                if (u.pn >= 8) { ss = add_xor16(ss); ss = add_xor32(ss); if (fq == 0) vss[(size_t)row * 32 + (u.pn - 8) * 4 + wc] = ss; } }
    }
};

struct EpiQKV {
    static constexpr bool PERM = true, HAS_PREF = true;
    bf16_t *Q, *Kall, *Vall, *Kc, *Vc; float *outk, *outv; const float* rope;
    const float* ssq; const float* sw;
    __device__ __forceinline__ void pref_direct(const Unit& u, LAS float* tab, int tid) const { cons_pref_direct(ssq, sw, 6144, u, tab, tid); }
    __device__ __forceinline__ void pref_dma(const Unit& u, LAS float* stg, int wid, int lane) const { cons_pref_dma(ssq, sw, 6144, u, stg, wid, lane); }
    __device__ __forceinline__ void pref_commit(const LAS float* stg, LAS float* tab, int tid) const { cons_pref_commit(stg, tab, tid); }
    __device__ __forceinline__ void post(const Unit&, const LAS float*, int) const {}
    __device__ __forceinline__ void operator()(f32x4 (&acc)[2][2][4][2], const Unit& u, int wr, int wc, int fr, int fq, const LAS float* rt, LAS float*) const {
        { const LAS float* swp = rt + 256 + wc * 32 + 8 * fq;
          f32x4 sv[2][2];
#pragma unroll
          for (int bj = 0; bj < 2; ++bj)
#pragma unroll
              for (int n = 0; n < 2; ++n) sv[bj][n] = *(const LAS f32x4*)(swp + bj * HALF + 4 * n);
#pragma unroll
          for (int ai = 0; ai < 2; ++ai)
#pragma unroll
              for (int m = 0; m < 4; ++m) { const float rs = rt[ai * HALF + wr * 64 + m * 16 + fr];
#pragma unroll
                  for (int bj = 0; bj < 2; ++bj)
#pragma unroll
                      for (int n = 0; n < 2; ++n) acc[ai][bj][m][n] = acc[ai][bj][m][n] * rs + sv[bj][n]; } }
        const bool ctx = u.pm < 32;
        const int row0 = u.pm * BM + wr * 64 + fr;
        const int lb = ctx ? 0 : ((u.pm - 32) >> 4);
        if (u.pn < 16) {
            const int sec = u.pn >> 3, h = u.pn & 7, mp = wc >> 1, axis = wc & 1;
            const int nat0 = h * 256 + mp * 128 + axis * 64 + 8 * fq;
            if (ctx) {
                bf16_t* dst = sec ? Kc : Q;
#pragma unroll
                for (int ai = 0; ai < 2; ++ai)
#pragma unroll
                    for (int m = 0; m < 4; ++m) { const int row = row0 + ai * HALF + m * 16;
#pragma unroll
                        for (int bj = 0; bj < 2; ++bj) { const f32x4 v0 = acc[ai][bj][m][0], v1 = acc[ai][bj][m][1]; const size_t o = (size_t)row * DM + nat0 + bj * 32;
                            u32x4 w; w.x = cvt_pk_bf16(v0[0], v0[1]); w.y = cvt_pk_bf16(v0[2], v0[3]); w.z = cvt_pk_bf16(v1[0], v1[1]); w.w = cvt_pk_bf16(v1[2], v1[3]);
                            *(u32x4*)(dst + o) = w;
                            if (sec) { *(f32x4*)(outk + o) = v0; *(f32x4*)(outk + o + 4) = v1; } } }
            } else {
#pragma unroll
                for (int am = 0; am < 4; ++am) { const int ai = am >> 1, mb = (am & 1) * 2;
                    f32x4 cs[2][4];
#pragma unroll
                    for (int m_ = 0; m_ < 2; ++m_) { const int row = row0 + ai * HALF + (mb + m_) * 16; const int t = (row - NCTX) & (LATSEQ - 1); const int pos = axis ? (t & 63) : (t >> 6);
                        const f32x4* rp = (const f32x4*)(rope + (size_t)(pos * 32 + 8 * fq) * 2);
#pragma unroll
                        for (int j = 0; j < 4; ++j) cs[m_][j] = rp[j]; }
#pragma unroll
                    for (int m_ = 0; m_ < 2; ++m_) { const int m = mb + m_; const int row = row0 + ai * HALF + m * 16; const int t = (row - NCTX) & (LATSEQ - 1);
                        const float cc[8] = {cs[m_][0][0], cs[m_][0][2], cs[m_][1][0], cs[m_][1][2], cs[m_][2][0], cs[m_][2][2], cs[m_][3][0], cs[m_][3][2]};
                        const float sn[8] = {cs[m_][0][1], cs[m_][0][3], cs[m_][1][1], cs[m_][1][3], cs[m_][2][1], cs[m_][2][3], cs[m_][3][1], cs[m_][3][3]};
                        float o1[8], o2[8];
#pragma unroll
                        for (int n = 0; n < 2; ++n)
#pragma unroll
                            for (int i = 0; i < 4; ++i) { const float x1 = acc[ai][0][m][n][i], x2 = acc[ai][1][m][n][i]; const float c = cc[n * 4 + i], sv = sn[n * 4 + i];
                                o1[n * 4 + i] = x1 * c - x2 * sv; o2[n * 4 + i] = x2 * c + x1 * sv; }
                        bf16_t* dp = sec ? (Kall + ((size_t)lb * KVLEN + PAST + t) * DM + nat0) : (Q + (size_t)row * DM + nat0);
                        u32x4 w; w.x = cvt_pk_bf16(o1[0], o1[1]); w.y = cvt_pk_bf16(o1[2], o1[3]); w.z = cvt_pk_bf16(o1[4], o1[5]); w.w = cvt_pk_bf16(o1[6], o1[7]);
                        *(u32x4*)dp = w;
                        w.x = cvt_pk_bf16(o2[0], o2[1]); w.y = cvt_pk_bf16(o2[2], o2[3]); w.z = cvt_pk_bf16(o2[4], o2[5]); w.w = cvt_pk_bf16(o2[6], o2[7]);
                        *(u32x4*)(dp + 32) = w; }
                }
            }
        } else {
            const int col0 = (u.pn - 16) * BM + wc * 32 + 8 * fq;
#pragma unroll
            for (int ai = 0; ai < 2; ++ai)
#pragma unroll
                for (int m = 0; m < 4; ++m) { const int row = row0 + ai * HALF + m * 16; const int t = (row - NCTX) & (LATSEQ - 1);
                    bf16_t* dp = ctx ? (Vc + (size_t)row * DM + col0) : (Vall + ((size_t)lb * KVLEN + PAST + t) * DM + col0);
#pragma unroll
                    for (int bj = 0; bj < 2; ++bj) { const f32x4 v0 = acc[ai][bj][m][0], v1 = acc[ai][bj][m][1];
                        u32x4 w; w.x = cvt_pk_bf16(v0[0], v0[1]); w.y = cvt_pk_bf16(v0[2], v0[3]); w.z = cvt_pk_bf16(v1[0], v1[1]); w.w = cvt_pk_bf16(v1[2], v1[3]);
                        *(u32x4*)(dp + bj * HALF) = w;
                        if (ctx) { float* op = outv + (size_t)row * DM + col0 + bj * HALF; *(f32x4*)op = v0; *(f32x4*)(op + 4) = v1; } } }
        }
    }
};

template <class Epi, class Sched>
__device__ __forceinline__ void gemm_phase(LAS unsigned char* lds, const Gemm g, const Sched& S, const Epi& E) {
    const int tid = opaque_tid(), wid = __builtin_amdgcn_readfirstlane(tid >> 6), lane = tid & 63, wr = wid >> 2, wc = wid & 3, fr = lane & 15, fq = lane >> 4;
    const int K = g.K, nt = K / BK, lda = g.lda;
    unsigned voffA[2], voffB[2];
#pragma unroll
    for (int i = 0; i < 2; ++i) { int R, C; stage_rc(tid * 16 + i * 8192, R, C); const int Rb = Epi::PERM ? ((R & ~31) + perm32(R & 31)) : R;
        voffA[i] = (unsigned)(R * lda + C) * 2u; voffB[i] = (unsigned)(Rb * K + C) * 2u; }
    const size_t kstep = (size_t)(BK * 2), kstepA = g.kstepA;
    const size_t hstepA = (size_t)HALF * lda * 2, hstepB = (size_t)HALF * K * 2;
    const unsigned ldsw = (unsigned)wid * 1024u;
    const int aoff = lds_byte(wr * 64 + fr, fq * 8), boff = lds_byte(wc * 32 + fr, fq * 8);
#define PG8_SA(b, h) (((b) * 2 + (h)) * HTB)
#define PG8_SB(b, h) ((4 + (b) * 2 + (h)) * HTB)
#define PG8_STAGE(bufoff, gbase, voff) do { _Pragma("unroll") for (int _i = 0; _i < 2; ++_i) \
        __builtin_amdgcn_global_load_lds((const unsigned*)((const char*)(gbase) + (voff)[_i]), (LAS unsigned*)(lds + (bufoff) + ldsw + _i * 8192), 16, 0, 0); } while (0)
#define PG8_LDA(dst, b, h) do { _Pragma("unroll") for (int m = 0; m < 4; ++m) _Pragma("unroll") for (int k = 0; k < 2; ++k) dst[m][k] = *(const LAS bf16x8*)(lds + PG8_SA(b, h) + aoff + m * 2048 + k * 1024); } while (0)
#define PG8_LDB(dst, b, h) do { _Pragma("unroll") for (int n = 0; n < 2; ++n) _Pragma("unroll") for (int k = 0; k < 2; ++k) dst[n][k] = *(const LAS bf16x8*)(lds + PG8_SB(b, h) + boff + n * 2048 + k * 1024); } while (0)
#define PG8_MMA(ai, bj, At, Bt) do { __builtin_amdgcn_s_setprio(1); _Pragma("unroll") for (int m = 0; m < 4; ++m) _Pragma("unroll") for (int n = 0; n < 2; ++n) _Pragma("unroll") for (int k = 0; k < 2; ++k) \
        acc[ai][bj][m][n] = __builtin_amdgcn_mfma_f32_16x16x32_bf16(Bt[n][k], At[m][k], acc[ai][bj][m][n], 0, 0, 0); __builtin_amdgcn_s_setprio(0); } while (0)
#define PG8_WAIT_V(n) asm volatile("s_waitcnt vmcnt(" #n ")" ::: "memory")
#define PG8_WAIT_L(n) asm volatile("s_waitcnt lgkmcnt(" #n ")" ::: "memory")
#define PG8_BAR __builtin_amdgcn_s_barrier()
#define PG8_SCHED __builtin_amdgcn_sched_barrier(0)
    Unit cur, nxt, prv; int ui = 0;
    if (!S.next(0, cur)) return;
    prv = cur;
    LAS float* TAB = (LAS float*)(lds + RT_OFF);
    LAS float* STG = TAB + STG_FLOAT_OFF;
    if constexpr (Epi::HAS_PREF) E.pref_direct(cur, TAB, tid);
    f32x4 acc[2][2][4][2];
#pragma unroll
    for (int a = 0; a < 2; ++a)
#pragma unroll
        for (int b = 0; b < 2; ++b)
#pragma unroll
            for (int m = 0; m < 4; ++m)
#pragma unroll
                for (int n = 0; n < 2; ++n) acc[a][b][m][n] = (f32x4){0.f, 0.f, 0.f, 0.f};
    bf16x8 At[4][2], B0[2][2], B1[2][2];
    const char* cA = (const char*)g.A + (size_t)cur.pm * g.tstepA + (size_t)(cur.pn >> 1) * g.agrp * 2; const char* cB = (const char*)g.Bt + (size_t)cur.pn * 2 * hstepB;
    PG8_STAGE(PG8_SB(0, 0), cB, voffB); PG8_STAGE(PG8_SB(0, 1), cB + hstepB, voffB); PG8_STAGE(PG8_SA(0, 0), cA, voffA); PG8_STAGE(PG8_SA(0, 1), cA + hstepA, voffA);
    if (wr == 1) PG8_BAR;
    PG8_WAIT_V(2); PG8_BAR;
    PG8_STAGE(PG8_SB(1, 0), cB + kstep, voffB); PG8_STAGE(PG8_SA(1, 0), cA + kstepA, voffA); PG8_STAGE(PG8_SB(1, 1), cB + hstepB + kstep, voffB);
    PG8_WAIT_V(6); PG8_BAR;
    for (;;) {
        const bool has_next = S.next(ui + 1, nxt);
        const char* nA = has_next ? (const char*)g.A + (size_t)nxt.pm * g.tstepA + (size_t)(nxt.pn >> 1) * g.agrp * 2 : cA; const char* nB = has_next ? (const char*)g.Bt + (size_t)nxt.pn * 2 * hstepB : cB;
        for (int t = 0; t < nt; t += 2) {
            const bool last = (t == nt - 2);
            if constexpr (Epi::HAS_PREF) { if (last && has_next) E.pref_dma(nxt, STG, wid, lane); }
            const char* a1 = cA + (size_t)(t + 1) * kstepA;
            const char* a2 = last ? nA : cA + (size_t)(t + 2) * kstepA; const char* b2 = last ? nB : cB + (size_t)(t + 2) * kstep;
            const char* a3 = a2 + kstepA; const char* b3 = b2 + kstep;
            PG8_LDB(B0, 0, 0); PG8_LDB(B1, 0, 1); PG8_SCHED; PG8_LDA(At, 0, 0); PG8_STAGE(PG8_SA(1, 1), a1 + hstepA, voffA);
            PG8_WAIT_V(8); PG8_WAIT_L(0); PG8_BAR; PG8_MMA(0, 0, At, B0); PG8_MMA(0, 1, At, B1); PG8_BAR; PG8_SCHED;
            PG8_LDA(At, 0, 1); PG8_STAGE(PG8_SB(0, 0), b2, voffB); PG8_STAGE(PG8_SB(0, 1), b2 + hstepB, voffB); PG8_STAGE(PG8_SA(0, 0), a2, voffA);
            PG8_WAIT_V(8); PG8_WAIT_L(0); PG8_BAR; PG8_MMA(1, 0, At, B0); PG8_MMA(1, 1, At, B1); PG8_BAR; PG8_SCHED;
            PG8_LDB(B0, 1, 0); PG8_LDB(B1, 1, 1); PG8_SCHED; PG8_LDA(At, 1, 0); PG8_STAGE(PG8_SA(0, 1), a2 + hstepA, voffA);
            PG8_WAIT_V(8); PG8_WAIT_L(0); PG8_BAR; PG8_MMA(0, 0, At, B0); PG8_MMA(0, 1, At, B1); PG8_BAR; PG8_SCHED;
            PG8_LDA(At, 1, 1); PG8_STAGE(PG8_SB(1, 0), b3, voffB); PG8_STAGE(PG8_SB(1, 1), b3 + hstepB, voffB); PG8_STAGE(PG8_SA(1, 0), a3, voffA);
            PG8_WAIT_V(8); PG8_WAIT_L(0); PG8_BAR; PG8_MMA(1, 0, At, B0); PG8_MMA(1, 1, At, B1); PG8_BAR; PG8_SCHED;
        }
        if (wr == 0) PG8_BAR;
        if (ui > 0) E.post(prv, TAB + 2 * TAB_FLOATS + ((ui - 1) & 1) * SSX_FLOATS, tid);
        E(acc, cur, wr, wc, fr, fq, TAB + (ui & 1) * TAB_FLOATS, TAB + 2 * TAB_FLOATS + (ui & 1) * SSX_FLOATS);
        prv = cur;
        if (!has_next) break;
        if constexpr (Epi::HAS_PREF) E.pref_commit(STG, TAB + ((ui + 1) & 1) * TAB_FLOATS, tid);
#pragma unroll
        for (int a = 0; a < 2; ++a)
#pragma unroll
            for (int b = 0; b < 2; ++b)
#pragma unroll
                for (int m = 0; m < 4; ++m)
#pragma unroll
                    for (int n = 0; n < 2; ++n) acc[a][b][m][n] = (f32x4){0.f, 0.f, 0.f, 0.f};
        cur = nxt; cA = nA; cB = nB; ++ui;
        if (wr == 1) PG8_BAR;
    }
    PG8_WAIT_V(0);
    PG8_WAIT_L(0); PG8_BAR; asm volatile("" ::: "memory");
    E.post(prv, TAB + 2 * TAB_FLOATS + (ui & 1) * SSX_FLOATS, tid);
#undef PG8_SA
#undef PG8_SB
#undef PG8_STAGE
#undef PG8_LDA
#undef PG8_LDB
#undef PG8_MMA
#undef PG8_WAIT_V
#undef PG8_WAIT_L
#undef PG8_BAR
#undef PG8_SCHED
}
}

namespace att {
constexpr int D = 128, NW = 8, QBLK = 32, KVBLK = 64;
constexpr float SCALE = 0.088388347648318440f;
constexpr float THR = 8.f;
constexpr int LDQ = DM, LDK = DM;
constexpr size_t SHM_V = KVBLK * D * 2, SHM_K = KVBLK * D * 2, SHM_ATTN = 2 * SHM_V + 2 * SHM_K + NW * 64 * 4;
#define KSWZ(row, colB) ((row) * 256 + ((colB) ^ (((row) & 7) << 4)))
#define SBAR() __builtin_amdgcn_sched_barrier(0)
__device__ __forceinline__ int crow(int r, int hi) { return (r & 3) + 8 * (r >> 2) + 4 * hi; }
__device__ __forceinline__ unsigned cvtpk(float lo, float hi) { unsigned r; asm volatile("v_cvt_pk_bf16_f32 %0, %1, %2" : "=v"(r) : "v"(lo), "v"(hi)); return r; }
__device__ __forceinline__ void partialSM(f32x16& p0, f32x16& p1, float& m_reg, float& mn, float& alpha) {
  constexpr float C = SCALE * 1.4426950408889634f;
  float pmax = p0[0];
#pragma unroll
  for (int r = 1; r < 16; ++r) pmax = fmaxf(pmax, p0[r]);
#pragma unroll
  for (int r = 0; r < 16; ++r) pmax = fmaxf(pmax, p1[r]);
  { auto rr = __builtin_amdgcn_permlane32_swap(__float_as_uint(pmax), __float_as_uint(pmax), false, false);
    pmax = fmaxf(__uint_as_float(rr[0]), __uint_as_float(rr[1])); }
  if (__builtin_expect(__all(pmax - m_reg <= THR / SCALE), 1)) { mn = m_reg; alpha = 1.f; }
  else { mn = fmaxf(m_reg, pmax); alpha = __builtin_amdgcn_exp2f((m_reg - mn) * C); m_reg = mn; }
  float mnC = -mn * C;
#pragma unroll
  for (int r = 0; r < 16; ++r) p0[r] = fmaf(p0[r], C, mnC);
#pragma unroll
  for (int r = 0; r < 16; ++r) p1[r] = fmaf(p1[r], C, mnC);
#pragma unroll
  for (int r = 0; r < 16; ++r) p0[r] = __builtin_amdgcn_exp2f(p0[r]);
}
__device__ __forceinline__ void finishSM(f32x16& p0, f32x16& p1, float alpha, float& l_reg, bf16x8& pa0, bf16x8& pa1, bf16x8& pa2, bf16x8& pa3) {
#pragma unroll
  for (int r = 0; r < 16; ++r) p1[r] = __builtin_amdgcn_exp2f(p1[r]);
  float ps = 0;
#pragma unroll
  for (int r = 0; r < 16; ++r) ps += p0[r];
#pragma unroll
  for (int r = 0; r < 16; ++r) ps += p1[r];
  { auto rr = __builtin_amdgcn_permlane32_swap(__float_as_uint(ps), __float_as_uint(ps), false, false);
    ps = __uint_as_float(rr[0]) + __uint_as_float(rr[1]); }
  l_reg = l_reg * alpha + ps;
#define PK4(P, BASE, OUT) do { unsigned a0 = cvtpk(P[BASE + 0], P[BASE + 1]), a1 = cvtpk(P[BASE + 2], P[BASE + 3]);   \
    unsigned b0 = cvtpk(P[BASE + 4], P[BASE + 5]), b1 = cvtpk(P[BASE + 6], P[BASE + 7]);                              \
    auto r0 = __builtin_amdgcn_permlane32_swap(a0, b0, false, false); auto r1 = __builtin_amdgcn_permlane32_swap(a1, b1, false, false); \
    u32x4 w = {r0[0], r1[0], r0[1], r1[1]}; OUT = *reinterpret_cast<bf16x8*>(&w); } while (0)
  PK4(p0, 0, pa0); PK4(p0, 8, pa1); PK4(p1, 0, pa2); PK4(p1, 8, pa3);
#undef PK4
}
__device__ __forceinline__ void qkt(f32x16& p0, f32x16& p1, const bf16_t* Ks, const bf16x8* qr, int r32, int hi) {
  p0 = f32x16{}; p1 = f32x16{};
#pragma unroll
  for (int d0 = 0; d0 < 8; ++d0) { int cb = (d0 * 16 + hi * 8) * 2;
    bf16x8 b0 = *reinterpret_cast<const bf16x8*>((const char*)Ks + KSWZ(r32, cb));
    bf16x8 b1 = *reinterpret_cast<const bf16x8*>((const char*)Ks + KSWZ(32 + r32, cb));
    p0 = __builtin_amdgcn_mfma_f32_32x32x16_bf16(b0, qr[d0], p0, 0, 0, 0);
    p1 = __builtin_amdgcn_mfma_f32_32x32x16_bf16(b1, qr[d0], p1, 0, 0, 0); }
}
__device__ __forceinline__ int v_st(int k, int c) { const int kk = (k & ~0xC) | ((k & 4) << 1) | ((k & 8) >> 1); return ((kk >> 3) * 4 + (c >> 5)) * 512 + ((kk & 7) * 32 + (c & 31)) * 2; }
__device__ __forceinline__ int v_rd_base(int lane) { return ((lane & 3) << 3) | (((lane >> 2) & 3) << 6) | (((lane >> 4) & 1) << 5) | (((lane >> 5) & 1) << 8); }
constexpr int v_rd_off(int d0, int ks, int half) { return d0 * 512 + ks * 4096 + half * 2048; }
template <int OFF> __device__ __forceinline__ s16x4 tr_read(int vb) {
  s16x4 r; asm volatile("ds_read_b64_tr_b16 %0, %1 offset:%2" : "=&v"(r) : "v"(vb), "i"(OFF) : "memory"); return r;
}
template <int D0> __device__ __forceinline__ void pv_one(f32x16& od, int vb, bf16x8 pa0, bf16x8 pa1, bf16x8 pa2, bf16x8 pa3) {
  const s16x4 l0 = tr_read<v_rd_off(D0, 0, 0)>(vb), h0 = tr_read<v_rd_off(D0, 0, 1)>(vb), l1 = tr_read<v_rd_off(D0, 1, 0)>(vb), h1 = tr_read<v_rd_off(D0, 1, 1)>(vb);
  const s16x4 l2 = tr_read<v_rd_off(D0, 2, 0)>(vb), h2 = tr_read<v_rd_off(D0, 2, 1)>(vb), l3 = tr_read<v_rd_off(D0, 3, 0)>(vb), h3 = tr_read<v_rd_off(D0, 3, 1)>(vb);
  asm volatile("s_waitcnt lgkmcnt(0)" ::: "memory"); SBAR();
#define PK(L, H) (bf16x8){L[0], L[1], L[2], L[3], H[0], H[1], H[2], H[3]}
  od = __builtin_amdgcn_mfma_f32_32x32x16_bf16(pa0, PK(l0, h0), od, 0, 0, 0);
  od = __builtin_amdgcn_mfma_f32_32x32x16_bf16(pa1, PK(l1, h1), od, 0, 0, 0);
  od = __builtin_amdgcn_mfma_f32_32x32x16_bf16(pa2, PK(l2, h2), od, 0, 0, 0);
  od = __builtin_amdgcn_mfma_f32_32x32x16_bf16(pa3, PK(l3, h3), od, 0, 0, 0);
#undef PK
}
__device__ __forceinline__ void pv_d0(f32x16* o, int vb, bf16x8 pa0, bf16x8 pa1, bf16x8 pa2, bf16x8 pa3) {
  pv_one<0>(o[0], vb, pa0, pa1, pa2, pa3); pv_one<1>(o[1], vb, pa0, pa1, pa2, pa3); pv_one<2>(o[2], vb, pa0, pa1, pa2, pa3); pv_one<3>(o[3], vb, pa0, pa1, pa2, pa3);
}

__device__ __forceinline__ void attn_pass(const bf16_t* __restrict__ Qb, const bf16_t* __restrict__ Kh, const bf16_t* __restrict__ Vh, int seq, char* lds, f32x16 (&o)[4]) {
  const int tid = opaque_tid(), wid = tid >> 6, lane = tid & 63, r32 = lane & 31, hi = lane >> 5;
  bf16_t* V_lds = (bf16_t*)lds; bf16_t* K_lds = (bf16_t*)(lds + 2 * SHM_V);
  float* ws = (float*)(lds + 2 * SHM_V + 2 * SHM_K) + wid * 64; float* li_l = ws; float* al_l = ws + 32;
  float m_reg = -1e30f, l_reg = 0; bf16x8 qr[8];
#pragma unroll
  for (int d = 0; d < 4; ++d) o[d] = f32x16{};
  const bf16_t* Qw = Qb + (long)(wid * QBLK + r32) * LDQ + hi * 8;
#pragma unroll
  for (int d0 = 0; d0 < 8; ++d0) qr[d0] = *reinterpret_cast<const bf16x8*>(Qw + d0 * 16);
  const int sr = tid >> 4, sc = (tid & 15) * 8, vst0 = v_st(sr, sc), vst1 = v_st(32 + sr, sc);
  const int vb0 = (int)(uintptr_t)V_lds + v_rd_base(lane);
  struct { bf16x8 vs0, vs1, ks0, ks1; } sr_[1];
#define SLOAD(i, k0) do { sr_[i].vs0 = *reinterpret_cast<const bf16x8*>(&Vh[(long)((k0) + sr) * LDK + sc]); sr_[i].vs1 = *reinterpret_cast<const bf16x8*>(&Vh[(long)((k0) + 32 + sr) * LDK + sc]); \
    sr_[i].ks0 = *reinterpret_cast<const bf16x8*>(&Kh[(long)((k0) + sr) * LDK + sc]); sr_[i].ks1 = *reinterpret_cast<const bf16x8*>(&Kh[(long)((k0) + 32 + sr) * LDK + sc]); } while (0)
#define SWRITE(b, i) do { *(bf16x8*)((char*)V_lds + (b) * SHM_V + vst0) = sr_[i].vs0;          \
    *(bf16x8*)((char*)V_lds + (b) * SHM_V + vst1) = sr_[i].vs1; int kc = sc * 2;               \
    *(bf16x8*)((char*)K_lds + (b) * SHM_K + KSWZ(sr, kc)) = sr_[i].ks0;                       \
    *(bf16x8*)((char*)K_lds + (b) * SHM_K + KSWZ(32 + sr, kc)) = sr_[i].ks1; } while (0)
#define SWAIT() asm volatile("s_waitcnt vmcnt(0)" ::: "memory")
#define RESC(a) do { if (__any((a) < 1.f)) { if (hi == 0) al_l[r32] = (a); asm volatile("s_waitcnt lgkmcnt(0)" ::: "memory"); \
    _Pragma("unroll") for (int d = 0; d < 4; ++d) _Pragma("unroll") for (int r = 0; r < 16; ++r) o[d][r] *= al_l[crow(r, hi)]; } } while (0)
  f32x16 pA0, pA1, pB0, pB1; float mnA, mnB, alA, alB; bf16x8 pa0, pa1, pa2, pa3; const int NT = seq / KVBLK;
  constexpr int SE = 0, SO = 0;
  SLOAD(SE, 0); asm volatile("s_waitcnt vmcnt(0)" ::: "memory"); SWRITE(0, SE); __syncthreads();
  qkt(pA0, pA1, K_lds, qr, r32, hi); partialSM(pA0, pA1, m_reg, mnA, alA);
  SLOAD(SO, KVBLK);
  SWAIT(); SWRITE(1, SO); __syncthreads();
  for (int j = 1; j + 1 < NT; j += 2) {
    SBAR(); qkt(pB0, pB1, (bf16_t*)((char*)K_lds + SHM_K), qr, r32, hi);
    finishSM(pA0, pA1, alA, l_reg, pa0, pa1, pa2, pa3); SBAR();
    SLOAD(SO, (j + 1) * KVBLK); SBAR();
    pv_d0(o, vb0, pa0, pa1, pa2, pa3); partialSM(pB0, pB1, m_reg, mnB, alB);
    __syncthreads(); SWAIT(); SWRITE(0, SE);
    RESC(alB); __syncthreads();
    SBAR(); qkt(pA0, pA1, K_lds, qr, r32, hi);
    finishSM(pB0, pB1, alB, l_reg, pa0, pa1, pa2, pa3); SBAR();
    SLOAD(SE, (j + 2) * KVBLK); SBAR();
    pv_d0(o, vb0 + (int)SHM_V, pa0, pa1, pa2, pa3); partialSM(pA0, pA1, m_reg, mnA, alA);
    __syncthreads(); SWAIT(); SWRITE(1, SO);
    RESC(alA); __syncthreads();
  }
  SBAR(); qkt(pB0, pB1, (bf16_t*)((char*)K_lds + SHM_K), qr, r32, hi);
  finishSM(pA0, pA1, alA, l_reg, pa0, pa1, pa2, pa3); SBAR();
  pv_d0(o, vb0, pa0, pa1, pa2, pa3); partialSM(pB0, pB1, m_reg, mnB, alB);
  __syncthreads(); RESC(alB);
  finishSM(pB0, pB1, alB, l_reg, pa0, pa1, pa2, pa3); SBAR();
  pv_d0(o, vb0 + (int)SHM_V, pa0, pa1, pa2, pa3);
  if (hi == 0) li_l[r32] = l_reg; asm volatile("s_waitcnt lgkmcnt(0)" ::: "memory");
#pragma unroll
  for (int r = 0; r < 16; ++r) { const float rl = __builtin_amdgcn_rcpf(li_l[crow(r, hi)]);
#pragma unroll
    for (int d0 = 0; d0 < 4; ++d0) o[d0][r] *= rl; }
  __syncthreads();
#undef SLOAD
#undef SWRITE
#undef SWAIT
#undef RESC
}

#define ABAR() do { asm volatile("" ::: "memory"); __builtin_amdgcn_s_barrier(); asm volatile("" ::: "memory"); __builtin_amdgcn_sched_barrier(0); } while (0)
__device__ __forceinline__ void qkt_l(f32x16& p0, f32x16& p1, const LAS char* Ks, const bf16x8* qr, int r32, int hi) {
  p0 = f32x16{}; p1 = f32x16{};
#pragma unroll
  for (int d0 = 0; d0 < 8; ++d0) { const int cb = (d0 * 16 + hi * 8) * 2;
    const bf16x8 b0 = *(const LAS bf16x8*)(Ks + KSWZ(r32, cb));
    const bf16x8 b1 = *(const LAS bf16x8*)(Ks + KSWZ(32 + r32, cb));
    p0 = __builtin_amdgcn_mfma_f32_32x32x16_bf16(b0, qr[d0], p0, 0, 0, 0);
    p1 = __builtin_amdgcn_mfma_f32_32x32x16_bf16(b1, qr[d0], p1, 0, 0, 0);
    if ((d0 & 3) == 3) SBAR(); }
}
__device__ __forceinline__ void attn_pass2(const bf16_t* __restrict__ Qb, const bf16_t* __restrict__ Kh, const bf16_t* __restrict__ Vh, int seq, LAS unsigned char* lds, f32x16 (&o)[8]) {
  const int tid = opaque_tid(), wid = __builtin_amdgcn_readfirstlane(tid >> 6), lane = tid & 63, r32 = lane & 31, hi = lane >> 5;
  constexpr int KB0 = 0, VB0 = 32768, WS0 = 98304;
  LAS float* li_l = (LAS float*)(lds + WS0) + wid * 64; LAS float* al_l = li_l + 32;
  unsigned kof, vof;
  { const int q = wid * 64 + lane, row = q >> 4, cs = q & 15; kof = (unsigned)(row * LDK + ((cs ^ (row & 7)) << 3)) * 2u; }
  { const int B = (wid * 64 + lane) * 16, sub = B >> 9, within = B & 511;
    const int kk = (sub >> 2) * 8 + (within >> 6), k = (kk & ~0xC) | ((kk & 4) << 1) | ((kk & 8) >> 1), c = (sub & 3) * 32 + ((within & 63) >> 1);
    vof = (unsigned)(k * LDK + c) * 2u; }
#define DMA_TILE(buf, k0) do { const char* kb_ = (const char*)Kh + (size_t)(k0) * LDK * 2; const char* vb_ = (const char*)Vh + (size_t)(k0) * LDK * 2; \
    _Pragma("unroll") for (int i_ = 0; i_ < 2; ++i_) __builtin_amdgcn_global_load_lds((const unsigned*)(kb_ + (size_t)i_ * 32 * LDK * 2 + kof), (LAS unsigned*)(lds + KB0 + (buf) * 16384 + (wid + 8 * i_) * 1024), 16, 0, 0); \
    _Pragma("unroll") for (int i_ = 0; i_ < 4; ++i_) __builtin_amdgcn_global_load_lds((const unsigned*)(vb_ + (size_t)(i_ & 1) * 32 * LDK * 2 + (size_t)(i_ >> 1) * 256 + vof), (LAS unsigned*)(lds + VB0 + (buf) * 32768 + (wid + 8 * i_) * 1024), 16, 0, 0); } while (0)
#define RESC2(a) do { if (__any((a) < 1.f)) { if (hi == 0) al_l[r32] = (a); asm volatile("s_waitcnt lgkmcnt(0)" ::: "memory"); \
    _Pragma("unroll") for (int d = 0; d < 8; ++d) _Pragma("unroll") for (int r = 0; r < 16; ++r) o[d][r] *= al_l[crow(r, hi)]; } } while (0)
  float m_reg = -1e30f, l_reg = 0.f; bf16x8 qr[8];
#pragma unroll
  for (int d = 0; d < 8; ++d) o[d] = f32x16{};
  const bf16_t* Qw = Qb + (long)(wid * QBLK + r32) * LDQ + hi * 8;
#pragma unroll
  for (int d0 = 0; d0 < 8; ++d0) qr[d0] = *reinterpret_cast<const bf16x8*>(Qw + d0 * 16);
  const int vb0 = (int)(unsigned)(uintptr_t)(lds + VB0) + v_rd_base(lane);
  const int NT = seq / KVBLK;
  DMA_TILE(0, 0); DMA_TILE(1, KVBLK);
#define TILE(buf, j) do { \
    if ((j) + 1 < NT) asm volatile("s_waitcnt vmcnt(6)" ::: "memory"); else asm volatile("s_waitcnt vmcnt(0)" ::: "memory"); \
    ABAR(); \
    f32x16 p0, p1; float mn, alpha; bf16x8 pa0, pa1, pa2, pa3; \
    qkt_l(p0, p1, (const LAS char*)(lds + KB0 + (buf) * 16384), qr, r32, hi); \
    partialSM(p0, p1, m_reg, mn, alpha); \
    RESC2(alpha); \
    finishSM(p0, p1, alpha, l_reg, pa0, pa1, pa2, pa3); SBAR(); \
    pv_d0(o, vb0 + (buf) * 32768, pa0, pa1, pa2, pa3); pv_d0(o + 4, vb0 + (buf) * 32768 + 16384, pa0, pa1, pa2, pa3); \
    ABAR(); \
    if ((j) + 2 < NT) DMA_TILE(buf, ((j) + 2) * KVBLK); } while (0)
  for (int j = 0; j < NT; j += 2) { TILE(0, j); TILE(1, j + 1); }
  if (hi == 0) li_l[r32] = l_reg; asm volatile("s_waitcnt lgkmcnt(0)" ::: "memory");
#pragma unroll
  for (int r = 0; r < 16; ++r) { const float rl = __builtin_amdgcn_rcpf(li_l[crow(r, hi)]);
#pragma unroll
    for (int d = 0; d < 8; ++d) o[d][r] *= rl; }
#undef DMA_TILE
#undef RESC2
#undef TILE
}
}

#define XB_TMO      128
#define XB_XCNT(j)  (256  + 64 * (j))
#define XB_XSUB(j)  (1280 + 64 * (j))
#define XB_XGEN(j)  (2304 + 64 * (j))
#define XB_TOP      3328
#define XB_TOPGEN   3392
#define XCD_BAR_WORDS 3456
#define XB_SPIN_CAP (1u << 18)
__device__ __forceinline__ unsigned xb_ld(unsigned* p)              { return __hip_atomic_load(p, __ATOMIC_RELAXED, __HIP_MEMORY_SCOPE_AGENT); }
__device__ __forceinline__ unsigned xb_add(unsigned* p, unsigned v) { return __hip_atomic_fetch_add(p, v, __ATOMIC_RELAXED, __HIP_MEMORY_SCOPE_AGENT); }
__device__ __forceinline__ unsigned xb_xcc_id() { return (unsigned)__builtin_amdgcn_s_getreg((3 << 11) | 20) & 0xFu; }
#define XB_SPIN(cond, bar) do { unsigned _sp = 0; while (cond) { __builtin_amdgcn_s_sleep(1); \
    if ((++_sp & 255u) == 0u) { if (xb_ld(&(bar)[XB_TMO])) break; if (_sp > XB_SPIN_CAP) { atomicAdd(&(bar)[XB_TMO], 1u); break; } } } } while (0)
struct XcdBarrier { unsigned* bar; unsigned x; volatile LAS unsigned* st; };
__device__ __forceinline__ XcdBarrier xcd_barrier_post(unsigned* bar, volatile LAS unsigned* st) {
    XcdBarrier b; b.bar = bar; b.x = xb_xcc_id(); b.st = st;
    if (threadIdx.x == 0) (void)xb_add(&bar[XB_XCNT(b.x)], 1u);
    return b;
}
__device__ __forceinline__ void xcd_barrier_complete(unsigned* bar, unsigned x, unsigned& nloc, unsigned& nx) {
    const unsigned G = gridDim.x * gridDim.y * gridDim.z;
    unsigned sum, cnt, mine, sp = 0u;
    for (;;) {
        sum = 0u; cnt = 0u; mine = 0u;
#pragma unroll
        for (unsigned j = 0; j < 16; ++j) { const unsigned c = xb_ld(&bar[XB_XCNT(j)]); sum += c; cnt += (c > 0u) ? 1u : 0u; mine = (j == x) ? c : mine; }
        if (sum == G) break;
        __builtin_amdgcn_s_sleep(1);
        if ((++sp & 255u) == 0u) { if (xb_ld(&bar[XB_TMO])) break; if (sp > XB_SPIN_CAP) { atomicAdd(&bar[XB_TMO], 1u); break; } }
    }
    nloc = mine > 0u ? mine : 1u; nx = cnt > 0u ? cnt : 1u;
}
__device__ __forceinline__ void xcd_barrier(const XcdBarrier& b) {
    asm volatile("s_waitcnt vmcnt(0)" ::: "memory");
    __syncthreads();
    if (threadIdx.x == 0) {
        unsigned* bar = b.bar;
        __builtin_amdgcn_s_waitcnt(0);
        unsigned nloc = b.st[0], nx = b.st[1];
        if (nloc == 0u) { xcd_barrier_complete(bar, b.x, nloc, nx); b.st[0] = nloc; b.st[1] = nx; }
        const unsigned old = xb_add(&bar[XB_XSUB(b.x)], 1u);
        const unsigned gen = old / nloc;
        if (old + 1u == (gen + 1u) * nloc) {
            __builtin_amdgcn_fence(__ATOMIC_RELEASE, "agent");
            asm volatile("s_waitcnt vmcnt(0)" ::: "memory");
            const unsigned og = xb_add(&bar[XB_TOP], 1u);
            const unsigned tg = og / nx;
            if (og + 1u == (tg + 1u) * nx) xb_add(&bar[XB_TOPGEN], 1u);
            else XB_SPIN(xb_ld(&bar[XB_TOPGEN]) == tg, bar);
            __builtin_amdgcn_fence(__ATOMIC_ACQUIRE, "agent");
            xb_add(&bar[XB_XGEN(b.x)], 1u);
            asm volatile("s_waitcnt vmcnt(0)" ::: "memory");
        } else {
            XB_SPIN(xb_ld(&bar[XB_XGEN(b.x)]) == gen, bar);
            __builtin_amdgcn_fence(__ATOMIC_ACQUIRE, "agent");
            asm volatile("s_waitcnt vmcnt(0)" ::: "memory");
        }
    }
    __syncthreads();
}

template <int MODE>
__device__ __forceinline__ void rowop_phase(int G, int bx, const float* x0, const float* x1, const float* g, const float* shiftp, const float* scalep,
                                            float* rstd_out, bf16_t* hout, float* fout) {
    const int tid = opaque_tid(), wave = __builtin_amdgcn_readfirstlane(tid >> 6), lane = tid & 63;
    const int NWV = G * 8, gw = bx * 8 + wave, rpw = (MROWS + NWV - 1) / NWV;
    const int r0 = gw * rpw, r1 = (r0 + rpw < MROWS) ? r0 + rpw : MROWS;
    f32x4 gp[8], sh[8]; int cur_ci = -1;
    if (MODE == 2) {
#pragma unroll
        for (int j = 0; j < 4; ++j) { gp[2 * j] = ((const f32x4*)g)[(lane + 64 * j) * 2]; gp[2 * j + 1] = ((const f32x4*)g)[(lane + 64 * j) * 2 + 1]; }
    }
    for (int row = r0; row < r1; ++row) {
        const float* xr = row < NCTX ? x0 + (size_t)row * DM : x1 + (size_t)(row - NCTX) * DM;
        f32x4 v[8]; float s = 0.f;
        if (MODE == 2) {
            const u32x4* xr16 = (const u32x4*)((const bf16_t*)x0 + (size_t)row * DM) + lane; const u32x4* dr = (const u32x4*)(hout + (size_t)row * DM) + lane;
            u32x4 xa[4], da[4];
#pragma unroll
            for (int j = 0; j < 4; ++j) { xa[j] = xr16[64 * j]; da[j] = dr[64 * j]; }
#pragma unroll
            for (int j = 0; j < 4; ++j) { v[2 * j] = h4_to_f4((u32x2){xa[j].x, xa[j].y}) + bf4_to_f4((u32x2){da[j].x, da[j].y}); v[2 * j + 1] = h4_to_f4((u32x2){xa[j].z, xa[j].w}) + bf4_to_f4((u32x2){da[j].z, da[j].w});
                s += dot4(v[2 * j]); s += dot4(v[2 * j + 1]); }
        } else {
#pragma unroll
        for (int j = 0; j < 8; ++j) { v[j] = ((const f32x4*)xr)[lane + 64 * j]; s += dot4(v[j]); }
        }
        s = wave_sum(s);
        const float rs = 1.0f / sqrtf(s * (1.0f / DM) + EPS);
        if (MODE == 0) { if (lane == 0) rstd_out[row] = rs; continue; }
        if (MODE == 1) {
            const int ci = row < NCTX ? 8 : ((row - NCTX) >> 12);
            if (ci != cur_ci) { cur_ci = ci;
#pragma unroll
                for (int j = 0; j < 8; ++j) { const f32x4 gg = ((const f32x4*)g)[lane + 64 * j], scv = ((const f32x4*)(scalep + (size_t)ci * NMOD))[lane + 64 * j];
                    gp[j] = gg * (scv + 1.0f); sh[j] = ((const f32x4*)(shiftp + (size_t)ci * NMOD))[lane + 64 * j]; } }
            u32x2* o8 = (u32x2*)(hout + (size_t)row * DM) + lane;
#pragma unroll
            for (int j = 0; j < 8; ++j) { const f32x4 h = v[j] * rs * gp[j] + sh[j]; u32x2 w; w.x = cvt_pk_bf16(h.x, h.y); w.y = cvt_pk_bf16(h.z, h.w); o8[64 * j] = w; }
        }
        if (MODE == 2) { f32x4* o = (f32x4*)(fout + (size_t)row * DM);
#pragma unroll
            for (int j = 0; j < 4; ++j) { o[(lane + 64 * j) * 2] = v[2 * j] * rs * gp[2 * j]; o[(lane + 64 * j) * 2 + 1] = v[2 * j + 1] * rs * gp[2 * j + 1]; } }
    }
}

template <bool F16> struct PoolStage;
template <> struct PoolStage<true>  { typedef u32x2 T; static __device__ __forceinline__ f32x4 cvt(u32x2 r) { return h4_to_f4(r); } };
template <> struct PoolStage<false> { typedef f32x4 T; static __device__ __forceinline__ f32x4 cvt(f32x4 r) { return r; } };
template <int W>
__device__ __forceinline__ void pool_compute(const LAS f32x4* T, const LAS float* RL, int cq, int tl0, int t0, int s0, int s1, f32x4 gp, bf16_t* dcol) {
    constexpr int HW = W / 2, NR = W + 7;
    f32x4 r[NR];
    int rb = tl0 + 8 - HW; asm volatile("" : "+v"(rb));
    const LAS f32x4* Tb = T + rb * 64 + cq; const LAS float* Rb = RL + rb;
#pragma unroll
    for (int i = 0; i < NR; ++i) r[i] = Tb[i * 64] * Rb[i];
#pragma unroll
    for (int k = 0; k < 8; ++k) { const int t = t0 + tl0 + k; const int lo = (t - HW > s0) ? t - HW : s0, hi = (t - HW + W < s1) ? t - HW + W : s1;
        f32x4 sum = r[k];
#pragma unroll
        for (int i = 1; i < W; ++i) sum = sum + r[k + i];
        const f32x4 d = gp * (sum * (1.0f / (float)(hi - lo)) - r[k + HW]);
        u32x2 o; o.x = cvt_pk_bf16(d.x, d.y); o.y = cvt_pk_bf16(d.z, d.w);
        *(u32x2*)(dcol + (size_t)t * DM) = o; }
}
template <bool F16>
__device__ __forceinline__ void pool_phase(LAS unsigned char* lds, int G, int bx, const float* x0, const float* x1, const bf16_t* x16, const float* rstd, const float* ssq, const float* g, const float* scalep, bf16_t* dout) {
    LAS f32x4* T = (LAS f32x4*)lds;
    LAS float* RL = (LAS float*)(lds + 80 * 64 * 16);
    int tid = opaque_tid(), cq = tid & 63, ts = tid >> 6;
    constexpr int NU = (MROWS / 64) * 8;
    typedef typename PoolStage<F16>::T PT;
    PT preA[10], preB[F16 ? 10 : 1]; f32x4 prA, prB; unsigned pvA = 0u, pvB = 0u;
#define POOL_GEOM(u) const int tt = (u) >> 3, cb = (u) & 7, t0 = tt * 64, c0 = cb * 256 + 4 * cq; \
        int s0, s1, ci, radj; const float* xb; \
        if (t0 < NCTX) { s0 = t0 & ~(CTXSEQ - 1); s1 = s0 + CTXSEQ; xb = x0; radj = 0; ci = 8; } \
        else { s0 = NCTX + ((t0 - NCTX) & ~(LATSEQ - 1)); s1 = s0 + LATSEQ; xb = x1; radj = NCTX; ci = (t0 - NCTX) >> 12; }
#define POOL_LOAD(u, PRE, PR, PV) do { POOL_GEOM(u); (void)ci; PV = 0u; \
        _Pragma("unroll") for (int i = 0; i < 10; ++i) { const int j = ts + 8 * i, t = t0 - 8 + j; const int tc = t < s0 ? s0 : (t >= s1 ? s1 - 1 : t); \
            if constexpr (F16) PRE[i] = *(const PT*)(x16 + (size_t)tc * DM + c0); else PRE[i] = *(const PT*)(xb + (size_t)(tc - radj) * DM + c0); \
            PV |= ((j < 79 && t >= s0 && t < s1) ? 1u : 0u) << i; } \
        { const int j = tid >> 1, t = t0 - 8 + j; const int tc = t < s0 ? s0 : (t >= s1 ? s1 - 1 : t); \
          if (ssq) PR = *(const f32x4*)(ssq + (size_t)tc * 8 + (tid & 1) * 4); else { PR = (f32x4){0.f, 0.f, 0.f, 0.f}; PR.x = rstd[tc]; } \
          if (!(j < 79 && t >= s0 && t < s1)) PR = (f32x4){0.f, 0.f, 0.f, 0.f}; } } while (0)
#define POOL_UNIT(uu, PRE, PR, PV, UNEXT) do { \
        asm volatile("" : "+v"(tid)); cq = tid & 63; ts = tid >> 6; \
        _Pragma("unroll") for (int i = 0; i < 10; ++i) { const int j = ts + 8 * i; const f32x4 v = PoolStage<F16>::cvt(PRE[i]); \
            if (j < 80) T[j * 64 + cq] = ((PV >> i) & 1u) ? v : (f32x4){0.f, 0.f, 0.f, 0.f}; } \
        { float sq = (PR.x + PR.y) + (PR.z + PR.w); float rv; \
          if (ssq) { sq = add_xor1(sq); rv = 1.0f / sqrtf(sq * (1.0f / DM) + EPS); } else rv = PR.x; \
          if ((tid & 1) == 0 && (tid >> 1) < 80) RL[tid >> 1] = rv; } \
        __syncthreads(); \
        if ((UNEXT) < NU) POOL_LOAD(UNEXT, PRE, PR, PV); \
        { POOL_GEOM(uu); (void)xb; (void)radj; \
          const f32x4 gp = *(const f32x4*)(g + c0) * (*(const f32x4*)(scalep + (size_t)ci * NMOD + c0) + 1.0f); \
          const int wsel = cb >> 1; \
          if (wsel == 0) pool_compute<2>(T, RL, cq, ts * 8, t0, s0, s1, gp, dout + c0); \
          else if (wsel == 1) pool_compute<4>(T, RL, cq, ts * 8, t0, s0, s1, gp, dout + c0); \
          else if (wsel == 2) pool_compute<8>(T, RL, cq, ts * 8, t0, s0, s1, gp, dout + c0); \
          else pool_compute<16>(T, RL, cq, ts * 8, t0, s0, s1, gp, dout + c0); } \
        __syncthreads(); } while (0)
    int u = bx;
    if (u < NU) POOL_LOAD(u, preA, prA, pvA);
    if constexpr (F16) {
        if (u + G < NU) POOL_LOAD(u + G, preB, prB, pvB);
        for (; u < NU; u += 2 * G) {
            POOL_UNIT(u, preA, prA, pvA, u + 2 * G);
            if (u + G < NU) POOL_UNIT(u + G, preB, prB, pvB, u + 3 * G);
        }
    } else {
        for (; u < NU; u += G) POOL_UNIT(u, preA, prA, pvA, u + G);
        (void)preB; (void)prB; (void)pvB;
    }
#undef POOL_GEOM
#undef POOL_LOAD
#undef POOL_UNIT
}

__device__ __forceinline__ void sw_compute(LAS unsigned char* lds, int G, int bx, const bf16_t* Wt, int N, const float* shiftp  , float* out  ) {
    LAS float* ST = (LAS float*)lds;
    const int tid = opaque_tid(), wave = tid >> 6, lane = tid & 63;
    __syncthreads();
    { f32x4 sv[9];
#pragma unroll
      for (int k = 0; k < 9; ++k) sv[k] = *(const f32x4*)(shiftp + (size_t)k * NMOD + tid * 4);
#pragma unroll
      for (int k = 0; k < 9; ++k) *(LAS f32x4*)(ST + k * DM + tid * 4) = sv[k]; }
    __syncthreads();
    const int gw = bx * 8 + wave, NGW = G * 8;
    u32x2 wv[8], wn[8], wm[8];
    int n = gw;
    if (n < N) {
#pragma unroll
        for (int j = 0; j < 8; ++j) wn[j] = *(const u32x2*)(Wt + (size_t)n * DM + j * 256 + lane * 4); }
    if (n + NGW < N) {
#pragma unroll
        for (int j = 0; j < 8; ++j) wm[j] = *(const u32x2*)(Wt + (size_t)(n + NGW) * DM + j * 256 + lane * 4); }
    for (; n < N; n += NGW) {
#pragma unroll
        for (int j = 0; j < 8; ++j) { wv[j] = wn[j]; wn[j] = wm[j]; }
        if (n + 2 * NGW < N) {
#pragma unroll
            for (int j = 0; j < 8; ++j) wm[j] = *(const u32x2*)(Wt + (size_t)(n + 2 * NGW) * DM + j * 256 + lane * 4); }
        f32x4 wf[8];
#pragma unroll
        for (int j = 0; j < 8; ++j) wf[j] = (f32x4){__uint_as_float(wv[j].x << 16), __uint_as_float(wv[j].x & 0xffff0000u), __uint_as_float(wv[j].y << 16), __uint_as_float(wv[j].y & 0xffff0000u)};
#pragma unroll 1
        for (int ci = 0; ci < 9; ++ci) { f32x4 a = (f32x4){0.f, 0.f, 0.f, 0.f};
#pragma unroll
            for (int j = 0; j < 8; ++j) a = a + *(const LAS f32x4*)(ST + ci * DM + j * 256 + lane * 4) * wf[j];
            const float r = wave_sum((a.x + a.y) + (a.z + a.w));
            if (lane == 0) out[(size_t)ci * N + n] = r; }
    }
}

__device__ __forceinline__ void sgu_phase(LAS unsigned char* lds, int G, int bx, const bf16_t* Z, const float* vss, const float* ng, const bf16_t* Wbf, const float* bs, bf16_t* Sout) {
    const int tid = opaque_tid(), wave = tid >> 6, lane = tid & 63, r32 = lane & 31, hi = lane >> 5;
    LAS float* RS = (LAS float*)(lds + 131072);
    LAS float* EB = (LAS float*)(lds + 65536 + wave * 8192);
    const int sr = tid >> 4, sc = (tid & 15) * 8;
    const int pb = wave & 3, ct = wave >> 2;
    const int eg = lane & 7, rsub = lane >> 3;
    constexpr int NU = (MROWS / 128) * 8;
    bf16x8 raw[8]; f32x4 part[2];
#define SGU_PREFETCH(u) do { const int chunk_ = (u) >> 3, g_ = (u) & 7, row0_ = chunk_ * 128; \
        _Pragma("unroll") for (int kt = 0; kt < 2; ++kt) _Pragma("unroll") for (int c2 = 0; c2 < 2; ++c2) _Pragma("unroll") for (int hf = 0; hf < 2; ++hf) \
            raw[(kt * 2 + c2) * 2 + hf] = *(const bf16x8*)(Z + (size_t)(row0_ + kt * 64 + hf * 32 + sr) * 4096 + 2048 + g_ * 256 + c2 * 128 + sc); \
        { const f32x4* p_ = (const f32x4*)(vss + (size_t)(row0_ + (tid >> 2)) * 32 + (tid & 3) * 8); part[0] = p_[0]; part[1] = p_[1]; } } while (0)
    int u = bx;
    if (u < NU) SGU_PREFETCH(u);
    for (; u < NU; u += G) {
        const int chunk = u >> 3, g = u & 7, row0 = chunk * 128;
        { const f32x4 a = part[0] + part[1]; float sq = (a.x + a.y) + (a.z + a.w); sq = add_xor1(sq); sq = add_xor2(sq);
          if ((tid & 3) == 0) RS[tid >> 2] = 1.0f / sqrtf(sq * (1.0f / DM) + EPS); }
        __syncthreads();
#pragma unroll
        for (int kt = 0; kt < 2; ++kt)
#pragma unroll
            for (int c2 = 0; c2 < 2; ++c2)
#pragma unroll
                for (int hf = 0; hf < 2; ++hf) { const int q = kt * 64 + hf * 32 + sr, col = c2 * 128 + sc; const bf16x8 rw = raw[(kt * 2 + c2) * 2 + hf];
                    const float rs = RS[q]; const f32x4 n0 = *(const f32x4*)(ng + g * 256 + col) * rs, n1 = *(const f32x4*)(ng + g * 256 + col + 4) * rs;
                    u32x4 w; w.x = cvt_pk_bf16(bf2f((bf16_t)rw[0]) * n0.x, bf2f((bf16_t)rw[1]) * n0.y); w.y = cvt_pk_bf16(bf2f((bf16_t)rw[2]) * n0.z, bf2f((bf16_t)rw[3]) * n0.w);
                    w.z = cvt_pk_bf16(bf2f((bf16_t)rw[4]) * n1.x, bf2f((bf16_t)rw[5]) * n1.y); w.w = cvt_pk_bf16(bf2f((bf16_t)rw[6]) * n1.z, bf2f((bf16_t)rw[7]) * n1.w);
                    *(LAS u32x4*)(lds + (kt * 2 + c2) * 16384 + att::v_st(hf * 32 + sr, sc)) = w; }
        __syncthreads();
        bf16x8 ucur[8];
#pragma unroll
        for (int hh = 0; hh < 2; ++hh)
#pragma unroll
            for (int i = 0; i < 4; ++i) ucur[hh * 4 + i] = *(const bf16x8*)(Z + (size_t)(row0 + pb * 32 + rsub + 8 * i) * 4096 + g * 256 + ct * 128 + hh * 64 + eg * 8);
        bf16x8 pa[8];
#pragma unroll
        for (int kk = 0; kk < 8; ++kk) pa[kk] = *(const bf16x8*)(Wbf + ((size_t)(g * 128 + pb * 32 + r32)) * 128 + kk * 16 + hi * 8);
        f32x16 o[4];
#pragma unroll
        for (int d = 0; d < 4; ++d) o[d] = f32x16{};
        const int vb = (int)(unsigned)(uintptr_t)lds + ct * 16384 + att::v_rd_base(lane);
        att::pv_d0(o, vb, pa[0], pa[1], pa[2], pa[3]);
        att::pv_d0(o, vb + 2 * 16384, pa[4], pa[5], pa[6], pa[7]);
        if (u + G < NU) SGU_PREFETCH(u + G);
        float bias[16];
#pragma unroll
        for (int r = 0; r < 16; ++r) bias[r] = bs[g * 128 + pb * 32 + att::crow(r, hi)];
#pragma unroll
        for (int hh = 0; hh < 2; ++hh) {
#pragma unroll
            for (int dl = 0; dl < 2; ++dl)
#pragma unroll
                for (int r = 0; r < 16; ++r) { const int rw = att::crow(r, hi), cl = dl * 32 + r32; EB[rw * 64 + (cl ^ ((rw & 7) << 3))] = o[hh * 2 + dl][r] + bias[r]; }
            asm volatile("s_waitcnt lgkmcnt(0)" ::: "memory");
#pragma unroll
            for (int i = 0; i < 4; ++i) { const int rw = rsub + 8 * i; const LAS f32x4* ep = (const LAS f32x4*)(EB + rw * 64 + ((eg ^ (rw & 7)) << 3));
                const f32x4 v0 = ep[0], v1 = ep[1]; const bf16x8 uq = ucur[hh * 4 + i];
                u32x4 w; w.x = cvt_pk_bf16(bf2f((bf16_t)uq[0]) * v0.x, bf2f((bf16_t)uq[1]) * v0.y); w.y = cvt_pk_bf16(bf2f((bf16_t)uq[2]) * v0.z, bf2f((bf16_t)uq[3]) * v0.w);
                w.z = cvt_pk_bf16(bf2f((bf16_t)uq[4]) * v1.x, bf2f((bf16_t)uq[5]) * v1.y); w.w = cvt_pk_bf16(bf2f((bf16_t)uq[6]) * v1.z, bf2f((bf16_t)uq[7]) * v1.w);
                *(u32x4*)(Sout + (size_t)(row0 + pb * 32 + rw) * DM + g * 256 + ct * 128 + hh * 64 + eg * 8) = w; }
            asm volatile("s_waitcnt lgkmcnt(0)" ::: "memory");
        }
        __syncthreads();
    }
#undef SGU_PREFETCH
}

__device__ __forceinline__ float lam_of(const float* lamp, int lane) {
    const float a = lamp[lane] * lamp[128 + lane] + lamp[64 + lane] * lamp[192 + lane], b = lamp[256 + lane] * lamp[384 + lane] + lamp[320 + lane] * lamp[448 + lane];
    return expf(wave_sum(a)) - expf(wave_sum(b)) + LAM_INIT;
}
__device__ __forceinline__ void attn_phase(LAS unsigned char* lds, int G, int vcu, const bf16_t* Qb, bf16_t* Oout, const bf16_t* Kc, const bf16_t* Vc, const bf16_t* Kall, const bf16_t* Vall,
                                           float* scratch, const float* lamp, const float* subg) {
    const int NU = 256 + 1024;
    for (int u = vcu; u < NU; u += G) {
        size_t rowbase; const bf16_t *Kb, *Vb; int seq, h;
        if (u < 256) { const int b = u >> 3; h = u & 7; rowbase = (size_t)b * CTXSEQ; Kb = Kc + rowbase * DM; Vb = Vc + rowbase * DM; seq = CTXSEQ; }
        else { const int v = u - 256, bh = v >> 4, qb = v & 15, b = bh >> 3; h = bh & 7; rowbase = (size_t)NCTX + (size_t)b * LATSEQ + (size_t)qb * 256;
            Kb = Kall + (size_t)b * KVLEN * DM; Vb = Vall + (size_t)b * KVLEN * DM; seq = KVLEN; }
        f32x16 o[8];
        att::attn_pass2(Qb + rowbase * DM + h * 256, Kb + h * 256, Vb + h * 256, seq, lds, o);
        { int tid = opaque_tid(); f32x4* Sv = (f32x4*)(scratch + ((size_t)vcu * 512 + tid) * 128);
#pragma unroll
          for (int d = 0; d < 8; ++d)
#pragma unroll
              for (int q = 0; q < 4; ++q) Sv[d * 4 + q] = (f32x4){o[d][4 * q], o[d][4 * q + 1], o[d][4 * q + 2], o[d][4 * q + 3]}; }
        att::attn_pass2(Qb + rowbase * DM + h * 256 + 128, Kb + h * 256 + 128, Vb + h * 256, seq, lds, o);
        const int tid = opaque_tid(), wid = tid >> 6, lane = tid & 63, r32 = lane & 31, hi = lane >> 5;
        const f32x4* S = (const f32x4*)(scratch + ((size_t)vcu * 512 + tid) * 128);
        const float lam = lam_of(lamp, lane);
        float ss[16];
#pragma unroll
        for (int r = 0; r < 16; ++r) ss[r] = 0.f;
#pragma unroll
        for (int d = 0; d < 8; ++d)
#pragma unroll
            for (int q = 0; q < 4; ++q) { const f32x4 t = S[d * 4 + q];
#pragma unroll
                for (int i = 0; i < 4; ++i) { const float v = t[i] - lam * o[d][4 * q + i]; o[d][4 * q + i] = v; ss[4 * q + i] += v * v; } }
        bf16_t* Ob = Oout + (rowbase + wid * 32) * DM + h * 256 + r32;
        float gg[8];
#pragma unroll
        for (int d = 0; d < 8; ++d) gg[d] = subg[d * 32 + r32] * (1.0f - LAM_INIT);
#pragma unroll
        for (int r = 0; r < 16; ++r) { float sq = ss[r];
#pragma unroll
            for (int of = 1; of < 32; of <<= 1) sq += __shfl_xor(sq, of);
            const float rs = 1.0f / sqrtf(sq * (1.0f / 256.0f) + EPS);
            bf16_t* op = Ob + (size_t)att::crow(r, hi) * DM;
#pragma unroll
            for (int d = 0; d < 8; ++d) op[d * 32] = f2bf(o[d][r] * rs * gg[d]); }
    }
}

__device__ __forceinline__ void transpose_item(const float* W, int K, int N, bf16_t* WT, int k0, int n0, int drow0, LAS float* scr, int lane) {
#pragma unroll 8
    for (int i = 0; i < 32; ++i) { const int kk = 2 * i + (lane >> 5); scr[kk * 33 + (lane & 31)] = W[(size_t)(k0 + kk) * N + n0 + (lane & 31)]; }
    asm volatile("s_waitcnt lgkmcnt(0)" ::: "memory");
    const int c = lane & 7;
#pragma unroll
    for (int j = 0; j < 4; ++j) { const int n = (lane >> 3) + 8 * j; const LAS float* s = scr + (8 * c) * 33 + n;
        u32x4 o; o.x = cvt_pk_bf16(s[0 * 33], s[1 * 33]); o.y = cvt_pk_bf16(s[2 * 33], s[3 * 33]); o.z = cvt_pk_bf16(s[4 * 33], s[5 * 33]); o.w = cvt_pk_bf16(s[6 * 33], s[7 * 33]);
        *(u32x4*)(WT + (size_t)(drow0 + n) * K + k0 + 8 * c) = o; }
    asm volatile("s_waitcnt lgkmcnt(0)" ::: "memory");
}
__device__ __forceinline__ int qkv_drow(int n0) {
    if (n0 >= 4096) return n0;
    const int sec = n0 >> 11, wi = n0 & 2047, h = wi >> 8, rem = wi & 255, mp = rem >> 7, axis = (rem >> 6) & 1, half = (rem >> 5) & 1;
    return sec * 2048 + h * 256 + half * 128 + (mp * 2 + axis) * 32;
}
__device__ __forceinline__ int ffnin_drow(int n0) { const int bj = n0 >= FFH ? 1 : 0, jj = n0 - bj * FFH; return (jj >> 7) * 256 + bj * 128 + (jj & 127); }

struct Args { const float* in[24]; float* out; unsigned char* ws; int ph_lo, ph_hi, li, pad; };

struct DArgs { GAS const float* in[24]; GAS float* out; GAS unsigned char* ws; int ph_lo, ph_hi, li, pad; };
static_assert(sizeof(DArgs) == sizeof(Args), "argument block layout");
typedef const DArgs __attribute__((address_space(4))) CArgs;
__device__ __forceinline__ void prologue(LAS unsigned char* lds, CArgs* ap, int G, int bx) {
    CArgs& a = *ap;
#define AIN(k) ((const float*)a.in[k])
    const int tid = opaque_tid(), wave = tid >> 6, lane = tid & 63;
    unsigned char* ws = (unsigned char*)a.ws;
    {
        LAS float* ST = (LAS float*)lds;
        LAS float* RED = (LAS float*)(lds + 73728);
        const float* cvec = AIN(4); const float* cctx = AIN(5); const float* ada_w = AIN(6); const float* ada_b = AIN(7);
        float* MOD = (float*)(ws + WS_MOD);
        for (int i = tid; i < 9 * DM; i += 512) { const int ci = i >> 11, k = i & 2047; const float c = ci < 8 ? cvec[ci * DM + k] : cctx[k]; ST[i] = c / (1.0f + expf(-c)); }
        __syncthreads();
        const int cq = lane & 15, ks = lane >> 4;
        for (int au = bx; au < 768; au += G) {
            const int l = au / 192, col0 = (au % 192) * 64;
            const float* wp = ada_w + ((size_t)l * DM + wave * 256 + ks) * NMOD + col0 + 4 * cq;
            f32x4 acc[9];
#pragma unroll
            for (int ci = 0; ci < 9; ++ci) acc[ci] = (f32x4){0.f, 0.f, 0.f, 0.f};
#pragma unroll 4
            for (int it = 0; it < 64; ++it) { const f32x4 wv = *(const f32x4*)(wp + (size_t)it * 4 * NMOD); const int k = wave * 256 + it * 4 + ks;
#pragma unroll
                for (int ci = 0; ci < 9; ++ci) acc[ci] = acc[ci] + wv * ST[ci * DM + k]; }
#pragma unroll
            for (int ci = 0; ci < 9; ++ci)
#pragma unroll
                for (int i = 0; i < 4; ++i) { float v = acc[ci][i]; v += __shfl_xor(v, 16); v += __shfl_xor(v, 32); acc[ci][i] = v; }
            if (lane < 16) {
#pragma unroll
                for (int ci = 0; ci < 9; ++ci) *(LAS f32x4*)(RED + (wave * 16 + cq) * 36 + ci * 4) = acc[ci]; }
            __syncthreads();
            for (int t = tid; t < 576; t += 512) { const int ci = t >> 6, col = t & 63; float s = ada_b[l * NMOD + col0 + col];
#pragma unroll
                for (int w = 0; w < 8; ++w) s += RED[(w * 16 + (col >> 2)) * 36 + ci * 4 + (col & 3)];
                MOD[(size_t)(l * 9 + ci) * NMOD + col0 + col] = s; }
            __syncthreads();
        }
    }
    __syncthreads();
    {
        LAS float* scr = (LAS float*)(lds + wave * 16384);
        const int gw = bx * 8 + wave, NGW = G * 8;
        constexpr int I_POOL = 8 * 128, I_SIN = 32 * 128, I_SOUT = 32 * 64, I_QKV = 32 * 192, I_WO = 32 * 64, I_FIN = 4 * 32 * 352, I_FOUT = 4 * 88 * 64;
        constexpr int NITEMS = I_POOL + I_SIN + I_SOUT + I_QKV + I_WO + I_FIN + I_FOUT;
        for (int it = gw; it < NITEMS; it += NGW) {
            int r = it;
            if (r < I_POOL) { const int mat = r >> 7, q = r & 127, kb = q >> 4, nb = q & 15;
                transpose_item(AIN(10) + (size_t)mat * 512 * 512, 512, 512, (bf16_t*)(ws + WS_POOLW) + (size_t)mat * 512 * 512, kb * 64, nb * 32, nb * 32, scr, lane); continue; } r -= I_POOL;
            if (r < I_SIN) { const int kb = r >> 7, nb = r & 127; transpose_item(AIN(12), DM, 4096, (bf16_t*)(ws + WS_SGUIN), kb * 64, nb * 32, nb * 32, scr, lane); continue; } r -= I_SIN;
            if (r < I_SOUT) { const int kb = r >> 6, nb = r & 63; transpose_item(AIN(16), DM, DM, (bf16_t*)(ws + WS_SGUOUT), kb * 64, nb * 32, nb * 32, scr, lane); continue; } r -= I_SOUT;
            if (r < I_QKV) { const int kb = r / 192, nb = r % 192; transpose_item(AIN(17), DM, 6144, (bf16_t*)(ws + WS_WQKV), kb * 64, nb * 32, qkv_drow(nb * 32), scr, lane); continue; } r -= I_QKV;
            if (r < I_WO) { const int kb = r >> 6, nb = r & 63; transpose_item(AIN(20), DM, DM, (bf16_t*)(ws + WS_WO), kb * 64, nb * 32, nb * 32, scr, lane); continue; } r -= I_WO;
            if (r < I_FIN) { const int l = r / (32 * 352), q = r % (32 * 352), kb = q / 352, nb = q % 352;
                transpose_item(AIN(21) + (size_t)l * DM * 2 * FFH, DM, 2 * FFH, (bf16_t*)(ws + WS_FFNIN + (size_t)l * FFNIN_L), kb * 64, nb * 32, ffnin_drow(nb * 32), scr, lane); continue; } r -= I_FIN;
            { const int l = r / (88 * 64), q = r % (88 * 64), kb = q >> 6, nb = q & 63;
                transpose_item(AIN(22) + (size_t)l * FFH * DM, FFH, DM, (bf16_t*)(ws + WS_FFNOUT + (size_t)l * FFNOUT_L), kb * 64, nb * 32, nb * 32, scr, lane); }
        }
    }
    {
        const size_t gt = (size_t)bx * 512 + tid, NT = (size_t)G * 512;
        for (size_t i = gt; i < 8 * 128 * 128 / 8; i += NT) { const float* src = AIN(14) + i * 8; const f32x4 v0 = *(const f32x4*)src, v1 = *(const f32x4*)(src + 4);
            u32x4 w; w.x = cvt_pk_bf16(v0.x, v0.y); w.y = cvt_pk_bf16(v0.z, v0.w); w.z = cvt_pk_bf16(v1.x, v1.y); w.w = cvt_pk_bf16(v1.z, v1.w); *(u32x4*)((bf16_t*)(ws + WS_SGUWS) + i * 8) = w; }
        for (size_t i = gt; i < 64 * 32; i += NT) { const int pos = (int)(i >> 5), f = (int)(i & 31);
            const float inv = powf(10000.0f, -(float)f / 32.0f); const float angf = (float)pos * inv; const double ang = (double)angf;
            const double kq = rint(ang * 0.6366197723675814); double r = fma(-kq, 1.5707963267948966, ang); r = fma(-kq, 6.123233995736766e-17, r);
            const int q = ((int)kq) & 3; const double r2 = r * r;
            const double sn = r * (1.0 + r2 * (-1.0 / 6 + r2 * (1.0 / 120 + r2 * (-1.0 / 5040 + r2 * (1.0 / 362880 + r2 * (-1.0 / 39916800 + r2 * (1.0 / 6227020800.0)))))));
            const double cs = 1.0 + r2 * (-0.5 + r2 * (1.0 / 24 + r2 * (-1.0 / 720 + r2 * (1.0 / 40320 + r2 * (-1.0 / 3628800 + r2 * (1.0 / 479001600.0 + r2 * (-1.0 / 87178291200.0)))))));
            const double sv = (q == 0) ? sn : (q == 1) ? cs : (q == 2) ? -sn : -cs, cv = (q == 0) ? cs : (q == 1) ? -sn : (q == 2) ? -cs : sn;
            float* rp = (float*)(ws + WS_ROPE) + i * 2; rp[0] = (float)cv; rp[1] = (float)sv; }
    }
    rowop_phase<0>(G, bx, AIN(0), AIN(1), nullptr, nullptr, nullptr, (float*)(ws + WS_RSTD), nullptr, nullptr);
#undef AIN
}

__device__ __forceinline__ void cache_convert(CArgs* ap, int G, int bx) {
    CArgs& a = *ap;
    unsigned char* ws = (unsigned char*)a.ws;
    const int tid = opaque_tid();
    const size_t gt = (size_t)bx * 512 + tid, NT = (size_t)G * 512;
    const size_t NC8 = (size_t)8 * PAST * DM / 8;
    for (size_t i = gt; i < 2 * NC8; i += NT) { const bool isv = i >= NC8; const size_t j = isv ? i - NC8 : i; const size_t e = j * 8, b = e / ((size_t)PAST * DM), rem = e % ((size_t)PAST * DM);
        const float* src = (const float*)(isv ? a.in[3] : a.in[2]) + e; bf16_t* dst = (bf16_t*)(ws + (isv ? WS_VALL : WS_KALL)) + b * (size_t)KVLEN * DM + rem;
        const f32x4 v0 = *(const f32x4*)src, v1 = *(const f32x4*)(src + 4);
        u32x4 w; w.x = cvt_pk_bf16(v0.x, v0.y); w.y = cvt_pk_bf16(v0.z, v0.w); w.z = cvt_pk_bf16(v1.x, v1.y); w.w = cvt_pk_bf16(v1.z, v1.w); *(u32x4*)dst = w; }
}

__device__ __forceinline__ CArgs* kargs() { CArgs* p = (CArgs*)__builtin_amdgcn_kernarg_segment_ptr(); asm volatile("" : "+s"(p)); return p; }
#define KA (kargs())
__global__ void __launch_bounds__(512, 2) mk_fwd(Args a_unused) {
    extern __shared__ __attribute__((aligned(16))) unsigned char lds_raw[];
    LAS unsigned char* lds = (LAS unsigned char*)lds_raw;
    volatile LAS unsigned* MISC = (volatile LAS unsigned*)(lds + MISC_OFF);
    const int tid = threadIdx.x, lane = tid & 63, wave = __builtin_amdgcn_readfirstlane(tid >> 6);
    const int G0 = gridDim.x, bx0 = blockIdx.x;
    const int vcu0 = (G0 % 8 == 0) ? (bx0 % 8) * (G0 / 8) + bx0 / 8 : bx0;
    GAS unsigned char* ws0 = KA->ws;
    unsigned* ctl = (unsigned*)((unsigned char*)ws0 + WS_CTL);
    for (int u = tid; u < (LDS_BYTES - LDSCTL_OFF) / 4; u += 512) ((LAS unsigned*)(lds + LDSCTL_OFF))[u] = 0u;
    __syncthreads();
    XcdBarrier bar = xcd_barrier_post(ctl + CW_BAR + KA->li * XCD_BAR_WORDS, MISC + 8);
#if MK_ONE_LAUNCH
    constexpr int lo = 0, hi = NPH;
#else
    const int lo = KA->ph_lo, hi = KA->ph_hi;
#endif
#ifndef MK_MASK
#define MK_MASK 0xffff
#endif
#define EN(b) ((MK_MASK >> (b)) & 1)
#define IN(k) (lo <= (k) && (k) < hi)
#define SEAM(k) do { if ((k) + 1 < hi) { XcdBarrier b2_ = bar; asm volatile("" : "+s"(b2_.bar), "+s"(b2_.x)); xcd_barrier(b2_); } } while (0)

#define PHASE_BEGIN \
    int G = G0, bx = bx0, vcu = vcu0; GAS unsigned char* wsg = ws0; asm volatile("" : "+s"(G), "+s"(bx), "+s"(vcu), "+s"(wsg)); unsigned char* ws = (unsigned char*)wsg; \
    bf16_t* X = (bf16_t*)(ws + WS_X); float* MOD = (float*)(ws + WS_MOD); float* RSTD = (float*)(ws + WS_RSTD); \
    float* SSQ = (float*)(ws + WS_SSQ); float* SW = (float*)(ws + WS_SW); \
    bf16_t* Hb = (bf16_t*)(ws + WS_H); bf16_t* HID = (bf16_t*)(ws + WS_HID); \
    bf16_t* R3 = (bf16_t*)((float*)KA->out); \
    (void)vcu; (void)RSTD; (void)SSQ; (void)SW; (void)Hb; (void)HID; (void)R3; (void)MOD; (void)X;
#define LAYER_VARS \
    const int kind = (l == 3) ? 0 : l; const float* modl = MOD + (size_t)l * 9 * NMOD; \
    const float* xs0 = (const float*)KA->in[0]; const float* xs1 = (const float*)KA->in[1]; const bf16_t* xs16 = (l == 0) ? (const bf16_t*)nullptr : (const bf16_t*)X; \
    const float* gmix = ((const float*)KA->in[8]) + l * DM; const float* gffn = ((const float*)KA->in[9]) + l * DM; \
    (void)kind; (void)modl; (void)xs0; (void)xs1; (void)xs16; (void)gmix; (void)gffn;

    if (EN(0) && IN(0)) { PHASE_BEGIN prologue(lds, KA, G, bx); SEAM(0); }

    for (int l = 0; l < 4; ++l) {
        const int pb = 1 + 5 * l;
        if (IN(pb + 0)) { PHASE_BEGIN LAYER_VARS
            if (kind == 0) { if (EN(2)) {
                if (l == 0) {
#pragma unroll 1
                    for (int sidx = 0; sidx < 6; ++sidx) {
                        const bf16_t* Wt = (sidx < 4) ? (const bf16_t*)(ws + WS_FFNIN + (size_t)sidx * FFNIN_L) : (sidx == 4) ? (const bf16_t*)(ws + WS_SGUIN) : (const bf16_t*)(ws + WS_WQKV);
                        const int N = (sidx < 4) ? 2 * FFH : (sidx == 4) ? 4096 : 6144;
                        const float* shp = (sidx < 4) ? MOD + (size_t)sidx * 9 * NMOD + 3 * DM : MOD + (size_t)(sidx - 3) * 9 * NMOD;
                        float* outp = SW + ((sidx < 4) ? sidx * SW_G1_L : (sidx == 4) ? SW_SGU : SW_QKV);
                        sw_compute(lds, G, bx, Wt, N, shp, outp);
                    }
                    __syncthreads();
                }
                if (l == 0) pool_phase<false>(lds, G, bx, xs0, xs1, xs16, RSTD, (const float*)nullptr, gmix, modl + 1 * DM, HID);
                else pool_phase<true>(lds, G, bx, xs0, xs1, xs16, RSTD, (const float*)SSQ, gmix, modl + 1 * DM, HID); } }
            else if (kind == 1) { if (EN(3)) { const pg8::Gemm g = pg8::mk_gemm(Hb, (const bf16_t*)(ws + WS_SGUIN), DM, DM); pg8::StaticOrder S; S.init(MROWS, 4096, G, bx);
                pg8::EpiGelu E{HID, (float*)(ws + WS_VSS), SSQ, SW + SW_SGU}; pg8::gemm_phase(lds, g, S, E); } }
            else if (EN(4)) { cache_convert(KA, G, bx);
                const pg8::Gemm g = pg8::mk_gemm(Hb, (const bf16_t*)(ws + WS_WQKV), DM, DM); pg8::StaticOrder S; S.init(MROWS, 6144, G, bx);
                pg8::EpiQKV E{(bf16_t*)(ws + WS_Q), (bf16_t*)(ws + WS_KALL), (bf16_t*)(ws + WS_VALL), (bf16_t*)(ws + WS_KC), (bf16_t*)(ws + WS_VC),
                              ((float*)KA->out) + (size_t)MROWS * DM, ((float*)KA->out) + (size_t)MROWS * DM + (size_t)NCTX * DM, (const float*)(ws + WS_ROPE), SSQ, SW + SW_QKV};
                pg8::gemm_phase(lds, g, S, E); }
            SEAM(pb + 0);
        }
        if (IN(pb + 1)) { PHASE_BEGIN LAYER_VARS
            if (kind == 0) { if (EN(5)) { const int slot = l / 3; const pg8::Gemm g = pg8::mk_gemm(HID, (const bf16_t*)(ws + WS_POOLW) + (size_t)slot * DM * 512, DM, 512, 512); pg8::StaticOrder S; S.init(MROWS, DM, G, bx);
                pg8::EpiRes E{xs0, xs1, xs16, X, modl + 2 * DM, ((const float*)KA->in[11]) + slot * DM, SSQ, Hb, gffn, modl + 4 * DM}; pg8::gemm_phase(lds, g, S, E); } }
            else if (kind == 1) { if (EN(6)) sgu_phase(lds, G, bx, HID, (const float*)(ws + WS_VSS), ((const float*)KA->in[13]), (const bf16_t*)(ws + WS_SGUWS), ((const float*)KA->in[15]), R3); }
            else if (EN(7)) attn_phase(lds, G, vcu, (const bf16_t*)(ws + WS_Q), R3, (const bf16_t*)(ws + WS_KC), (const bf16_t*)(ws + WS_VC), (const bf16_t*)(ws + WS_KALL), (const bf16_t*)(ws + WS_VALL),
                            (float*)(ws + WS_ATTS), ((const float*)KA->in[18]), ((const float*)KA->in[19]));
            SEAM(pb + 1);
        }
        if (EN(8) && IN(pb + 2) && phase_nonempty(pb + 2)) { PHASE_BEGIN LAYER_VARS
            { const pg8::Gemm g = pg8::mk_gemm(R3, (const bf16_t*)(ws + (kind == 1 ? WS_SGUOUT : WS_WO)), DM, DM); pg8::StaticOrder S; S.init(MROWS, DM, G, bx);
                pg8::EpiRes E{nullptr, nullptr, X, X, modl + 2 * DM, nullptr, SSQ, Hb, gffn, modl + 4 * DM}; pg8::gemm_phase(lds, g, S, E); }
            SEAM(pb + 2);
        }
        if (EN(10) && IN(pb + 3)) { PHASE_BEGIN LAYER_VARS const pg8::Gemm g = pg8::mk_gemm(Hb, (const bf16_t*)(ws + WS_FFNIN + (size_t)l * FFNIN_L), DM, DM); pg8::StaticOrder S; S.init(MROWS, 2 * FFH, G, bx);
            pg8::EpiSwiglu E{HID, SSQ, SW + l * SW_G1_L}; pg8::gemm_phase(lds, g, S, E); SEAM(pb + 3); }
        if (EN(11) && IN(pb + 4)) { PHASE_BEGIN LAYER_VARS const pg8::Gemm g{HID, (const bf16_t*)(ws + WS_FFNOUT + (size_t)l * FFNOUT_L), 64, FFH, 0, 256u * 64u * 2u, (size_t)(FFH / 64) * 256 * 64 * 2}; pg8::StaticOrder S; S.init(MROWS, DM, G, bx, 4);
            const bool nxg = (l == 0 || l == 1);
            pg8::EpiRes E{nullptr, nullptr, X, X, modl + 5 * DM, nullptr, (l == 3) ? (float*)nullptr : SSQ, nxg ? Hb : (bf16_t*)nullptr, ((const float*)KA->in[8]) + (l + 1) * DM, MOD + (size_t)(l + 1) * 9 * NMOD + 1 * DM};
            if (l == 3) { pg8::EpiDelta ED{Hb, modl + 5 * DM, nullptr}; pg8::gemm_phase(lds, g, S, ED); }
            else pg8::gemm_phase(lds, g, S, E);
            SEAM(pb + 4); }
    }
    if (EN(12) && IN(21)) { PHASE_BEGIN rowop_phase<2>(G, bx, (const float*)X, nullptr, ((const float*)KA->in[23]), nullptr, nullptr, nullptr, Hb, ((float*)KA->out)); }
#undef PHASE_BEGIN
#undef LAYER_VARS
#undef IN
#undef SEAM
}

extern "C" void kernel_launch(void* const* d_in, const int* in_sizes, int n_in, void* d_out, int out_size, void* d_ws, size_t ws_size, hipStream_t stream) {
    static int grid = 0;
    if (grid == 0) {
        if (n_in != 24 || in_sizes[0] != NCTX * DM || in_sizes[1] != NLAT * DM || ws_size < WS_END) {
            fprintf(stderr, "kernel_launch: unexpected shapes: n_in %d in0 %d in1 %d out %d ws %zu (need %zu)\n", n_in, n_in > 0 ? in_sizes[0] : -1, n_in > 1 ? in_sizes[1] : -1, out_size, ws_size, (size_t)WS_END); grid = -1; return; }
        int dev = 0, cus = 0;
        if (hipGetDevice(&dev) != hipSuccess || hipDeviceGetAttribute(&cus, hipDeviceAttributeMultiprocessorCount, dev) != hipSuccess) { grid = -1; return; }
        if (hipFuncSetAttribute((const void*)mk_fwd, hipFuncAttributeMaxDynamicSharedMemorySize, LDS_BYTES) != hipSuccess) { fprintf(stderr, "kernel_launch: hipFuncSetAttribute failed\n"); grid = -1; return; }
        int per_cu = 0;
        if (hipOccupancyMaxActiveBlocksPerMultiprocessor(&per_cu, (const void*)mk_fwd, 512, LDS_BYTES) != hipSuccess || per_cu < 1) { fprintf(stderr, "kernel_launch: occupancy query says %d\n", per_cu); }
        (void)hipGetLastError();
        grid = cus > 0 ? cus : 256;
    }
    if (grid < 0) return;
    (void)hipMemsetAsync((char*)d_ws + WS_CTL, 0, CTL_ZERO_BYTES, stream);
    Args a{};
    for (int i = 0; i < 24; ++i) a.in[i] = (const float*)d_in[i];
    a.out = (float*)d_out; a.ws = (unsigned char*)d_ws; a.pad = 0;
#if MK_ONE_LAUNCH
    a.ph_lo = 0; a.ph_hi = NPH; a.li = 0;
    hipLaunchKernelGGL(mk_fwd, dim3(grid), dim3(512), LDS_BYTES, stream, a);
#else
    int li = 0;
    for (int p = 0; p < NPH; ++p) { if (!phase_nonempty(p)) continue; a.ph_lo = p; a.ph_hi = p + 1; a.li = li++;
        hipLaunchKernelGGL(mk_fwd, dim3(grid), dim3(512), LDS_BYTES, stream, a); }
#endif
    const hipError_t le = hipPeekAtLastError();
    if (le != hipSuccess) fprintf(stderr, "kernel_launch: launch failed: %s\n", hipGetErrorName(le));
}
```
